# Optimizing an MI355X kernel written in HIP

```python
import jax, jax.numpy as jnp
from jax import lax
import numpy as np

D_MODEL = 2048
BATCH = 8
SEQ = 2048
DEPTH = 2
DEC_BATCH = 8
DEC_SEQ = 4096
PAST_LEN = 128

HEAD_DIM = 64
N_BRANCH = 4
DIL_CONFIGS = ((128, 1), (512, 4), (2048, 16))
N_DIL = 3
A_HEADS = 8
B_HEADS = 8
Q_LORA = 384
KV_LORA = 128
QK_NOPE = 64
QK_ROPE = 32
V_DIM = 64
ROPE_THETA = 10000.0
Q_BLOCK = 128
C_HEADS = 8
C_KV_HEADS = 2
C_RADIUS = 128
LRU_WIDTH = 512
LRU_BLOCKS = 8
LRU_BLOCK = 64
CONV_W = 4
CONV_PAD_L = 2
LRU_C = 8.0
D_FF = 5632
EPS = 1e-6
NEG = -1e30

A_COLS = 3 * N_DIL * A_HEADS * HEAD_DIM
B_COLS = Q_LORA + KV_LORA + QK_ROPE
C_COLS = (C_HEADS + 2 * C_KV_HEADS) * HEAD_DIM
D_COLS = 2 * LRU_WIDTH
G_COLS = N_BRANCH * D_MODEL
N_IN = A_COLS + B_COLS + C_COLS + D_COLS + G_COLS
SPLITS = (A_COLS, A_COLS + B_COLS, A_COLS + B_COLS + C_COLS, A_COLS + B_COLS + C_COLS + D_COLS)

kernel_name = 'hybrid_bidir_encoder_gated_branches'


def rms_norm(x, g):
    xf = x.astype(jnp.float32)
    y = xf * lax.rsqrt(jnp.mean(xf * xf, axis=-1, keepdims=True) + EPS)
    return (y * g.astype(jnp.float32)).astype(x.dtype)


def swiglu(x, w1, w3, w2):
    return (jax.nn.silu(x @ w1) * (x @ w3)) @ w2


def alibi_slopes(n):
    return jnp.asarray(2.0 ** (-8.0 * np.arange(1, n + 1) / n), dtype=jnp.float32)


def banded_attention(q, k, v, radius, step, slopes, sink=None):
    n, length, h, dh = q.shape
    g = k.shape[2]
    rep = h // g
    blk = radius
    nb = -(-length // blk)
    pad = nb * blk - length
    qb = jnp.pad(q, ((0, 0), (0, pad), (0, 0), (0, 0))).reshape(n, nb, blk, g, rep, dh)
    kv_pad = ((0, 0), (blk, blk + pad), (0, 0), (0, 0))
    kb = jnp.pad(k, kv_pad).reshape(n, nb + 2, blk, g, dh)
    vb = jnp.pad(v, kv_pad).reshape(n, nb + 2, blk, g, dh)
    kw = jnp.concatenate([kb[:, :-2], kb[:, 1:-1], kb[:, 2:]], axis=2)
    vw = jnp.concatenate([vb[:, :-2], vb[:, 1:-1], vb[:, 2:]], axis=2)
    s = jnp.einsum('nbqgrd,nbkgd->nbgrqk', qb, kw).astype(jnp.float32) * (dh ** -0.5)
    rel = jnp.arange(3 * blk)[None, :] - blk - jnp.arange(blk)[:, None]
    kpos = jnp.arange(nb)[:, None] * blk + jnp.arange(3 * blk)[None, :] - blk
    mask = (jnp.abs(rel) <= radius)[None] & ((kpos >= 0) & (kpos < length))[:, None, :]
    bias = -slopes.reshape(g, rep)[:, :, None, None] * (step * jnp.abs(rel)).astype(jnp.float32)
    s = jnp.where(mask[None, :, None, None], s + bias[None, None], NEG)
    m = jnp.max(s, axis=-1)
    if sink is not None:
        sk = sink.astype(jnp.float32).reshape(g, rep)[None, None, :, :, None]
        m = jnp.maximum(m, sk)
    p = jnp.exp(s - m[..., None])
    l = jnp.sum(p, axis=-1)
    if sink is not None:
        l = l + jnp.exp(sk - m)
    o = jnp.einsum('nbgrqk,nbkgd->nbqgrd', p.astype(v.dtype), vw).astype(jnp.float32)
    o = (o / jnp.moveaxis(l, -1, 2)[..., None]).astype(v.dtype)
    lse = jnp.moveaxis(m + jnp.log(l), -1, 2)
    o = o.reshape(n, nb * blk, h, dh)[:, :length]
    lse = lse.reshape(n, nb * blk, h)[:, :length]
    return o, lse


def to_residue_classes(t, dil):
    b, s = t.shape[:2]
    return t.reshape(b, s // dil, dil, *t.shape[2:]).swapaxes(1, 2).reshape(b * dil, s // dil, *t.shape[2:])


def from_residue_classes(t, b, dil):
    sub = t.shape[1]
    return t.reshape(b, dil, sub, *t.shape[2:]).swapaxes(1, 2).reshape(b, sub * dil, *t.shape[2:])


def dilated_attention(pa):
    b, s = pa.shape[:2]
    qkv = pa.reshape(b, s, 3, N_DIL, A_HEADS, HEAD_DIM)
    slopes = alibi_slopes(A_HEADS)
    outs, lses = [], []
    for gi, (window, dil) in enumerate(DIL_CONFIGS):
        q = to_residue_classes(qkv[:, :, 0, gi], dil)
        k = to_residue_classes(qkv[:, :, 1, gi], dil)
        v = to_residue_classes(qkv[:, :, 2, gi], dil)
        o, lse = banded_attention(q, k, v, window // (2 * dil), dil, slopes)
        outs.append(from_residue_classes(o, b, dil).astype(jnp.float32))
        lses.append(from_residue_classes(lse, b, dil))
    alpha = jax.nn.softmax(jnp.stack(lses, axis=0), axis=0)
    out = jnp.sum(alpha[..., None] * jnp.stack(outs, axis=0), axis=0)
    return out.reshape(b, s, A_HEADS * HEAD_DIM).astype(pa.dtype)


def rope_tables(s):
    inv = ROPE_THETA ** (-jnp.arange(0, QK_ROPE, 2, dtype=jnp.float32) / QK_ROPE)
    ang = jnp.arange(s, dtype=jnp.float32)[:, None] * inv[None, :]
    return jnp.cos(ang), jnp.sin(ang)


def apply_rope(x, cos, sin):
    x1, x2 = jnp.split(x.astype(jnp.float32), 2, axis=-1)
    c, sn = cos[None, :, None, :], sin[None, :, None, :]
    return jnp.concatenate([x1 * c - x2 * sn, x1 * sn + x2 * c], axis=-1).astype(x.dtype)


def mla(pb, q_norm, w_uq, kv_norm, w_ukv):
    b, s = pb.shape[:2]
    cq = pb[..., :Q_LORA]
    ckv = pb[..., Q_LORA:Q_LORA + KV_LORA]
    kr = pb[..., Q_LORA + KV_LORA:]
    q = (rms_norm(cq, q_norm) @ w_uq).reshape(b, s, B_HEADS, QK_NOPE + QK_ROPE)
    kv = (rms_norm(ckv, kv_norm) @ w_ukv).reshape(b, s, B_HEADS, QK_NOPE + V_DIM)
    cos, sin = rope_tables(s)
    q_nope = q[..., :QK_NOPE]
    q_rope = apply_rope(q[..., QK_NOPE:], cos, sin)
    k_nope, v = kv[..., :QK_NOPE], kv[..., QK_NOPE:]
    k_rope = apply_rope(kr[:, :, None, :], cos, sin)[:, :, 0]
    scale = (QK_NOPE + QK_ROPE) ** -0.5
    nb = s // Q_BLOCK
    qn = q_nope.reshape(b, nb, Q_BLOCK, B_HEADS, QK_NOPE).swapaxes(0, 1)
    qr = q_rope.reshape(b, nb, Q_BLOCK, B_HEADS, QK_ROPE).swapaxes(0, 1)

    def query_block(args):
        qn_b, qr_b = args
        sc = (jnp.einsum('bqhd,bkhd->bhqk', qn_b, k_nope)
              + jnp.einsum('bqhr,bkr->bhqk', qr_b, k_rope)).astype(jnp.float32) * scale
        p = jax.nn.softmax(sc, axis=-1)
        return jnp.einsum('bhqk,bkhd->bqhd', p.astype(v.dtype), v)

    o = lax.map(query_block, (qn, qr))
    return o.swapaxes(0, 1).reshape(b, s, B_HEADS * V_DIM)


def windowed_gqa_sink(pc, sink):
    b, s = pc.shape[:2]
    q = pc[..., :C_HEADS * HEAD_DIM].reshape(b, s, C_HEADS, HEAD_DIM)
    k = pc[..., C_HEADS * HEAD_DIM:(C_HEADS + C_KV_HEADS) * HEAD_DIM].reshape(b, s, C_KV_HEADS, HEAD_DIM)
    v = pc[..., (C_HEADS + C_KV_HEADS) * HEAD_DIM:].reshape(b, s, C_KV_HEADS, HEAD_DIM)
    o, _ = banded_attention(q, k, v, C_RADIUS, 1, alibi_slopes(C_HEADS), sink)
    return o.reshape(b, s, C_HEADS * HEAD_DIM)


def lru_combine(c1, c2):
    a1, u1 = c1
    a2, u2 = c2
    return a1 * a2, a2 * u1 + u2


def rg_lru_scan(xc, w_a, b_a, w_x, b_x, lam, reverse):
    b, s, w = xc.shape
    xb = xc.reshape(b, s, LRU_BLOCKS, LRU_BLOCK)
    r = jax.nn.sigmoid(jnp.einsum('bsne,nef->bsnf', xb, w_a).reshape(b, s, w) + b_a)
    i = jax.nn.sigmoid(jnp.einsum('bsne,nef->bsnf', xb, w_x).reshape(b, s, w) + b_x)
    log_a = -LRU_C * r.astype(jnp.float32) * jax.nn.softplus(-lam.astype(jnp.float32))
    a = jnp.exp(log_a)
    u = jnp.sqrt(-jnp.expm1(2.0 * log_a)) * (i * xc).astype(jnp.float32)
    _, hs = lax.associative_scan(lru_combine, (a, u), reverse=reverse, axis=1)
    return hs


def recurrent_branch(pd, conv_w, conv_b, w_a, b_a, w_x, b_x, lam):
    s = pd.shape[1]
    xr, gate = pd[..., :LRU_WIDTH], pd[..., LRU_WIDTH:]
    xp = jnp.pad(xr, ((0, 0), (CONV_PAD_L, CONV_W - 1 - CONV_PAD_L), (0, 0)))
    xc = conv_b
    for tap in range(CONV_W):
        xc = xc + xp[:, tap:tap + s] * conv_w[tap]
    h = (rg_lru_scan(xc, w_a[0], b_a[0], w_x[0], b_x[0], lam[0], False)
         + rg_lru_scan(xc, w_a[1], b_a[1], w_x[1], b_x[1], lam[1], True))
    return h.astype(pd.dtype) * jax.nn.gelu(gate, approximate=True)


def trunk(x, ffn1_norm, ffn1_w1, ffn1_w3, ffn1_w2, mix_norm, w_in, mla_q_norm, mla_w_uq, mla_kv_norm,
          mla_w_ukv, lru_conv_w, lru_conv_b, lru_w_a, lru_b_a, lru_w_x, lru_b_x, lru_lambda, sink_logits,
          w_branch, w_out, ffn2_norm, ffn2_w1, ffn2_w3, ffn2_w2, final_norm):
    for l in range(DEPTH):
        x = x + 0.5 * swiglu(rms_norm(x, ffn1_norm[l]), ffn1_w1[l], ffn1_w3[l], ffn1_w2[l])
        h = rms_norm(x, mix_norm[l])
        pa, pb, pc, pd, pg = jnp.split(h @ w_in[l], SPLITS, axis=-1)
        branches = (
            dilated_attention(pa),
            mla(pb, mla_q_norm[l], mla_w_uq[l], mla_kv_norm[l], mla_w_ukv[l]),
            windowed_gqa_sink(pc, sink_logits[l]),
            recurrent_branch(pd, lru_conv_w[l], lru_conv_b[l], lru_w_a[l], lru_b_a[l], lru_w_x[l],
                             lru_b_x[l], lru_lambda[l]),
        )
        merged = None
        for nbr, y in enumerate(branches):
            gate = jax.nn.sigmoid(pg[..., nbr * D_MODEL:(nbr + 1) * D_MODEL])
            term = gate * (y @ w_branch[l, nbr])
            merged = term if nbr == 0 else merged + term
        x = x + merged @ w_out[l]
        x = x + 0.5 * swiglu(rms_norm(x, ffn2_norm[l]), ffn2_w1[l], ffn2_w3[l], ffn2_w2[l])
    return rms_norm(x, final_norm)


def setup_inputs(seed: int = 0) -> dict:
    key = jax.random.key(seed)
    ks = jax.random.split(key, 32)
    f32 = jnp.float32

    def nrm(k, shape, scale):
        return jax.random.normal(k, shape, f32) * scale

    def gain(k, shape):
        return 1.0 + 0.02 * jax.random.normal(k, shape, f32)

    L = DEPTH
    u = jax.random.uniform(ks[18], (L, 2, LRU_WIDTH), f32, 0.9, 0.999)
    return {
        'x_prompt': nrm(ks[0], (BATCH, SEQ, D_MODEL), 1.0),
        'x_sample': nrm(ks[1], (DEC_BATCH, DEC_SEQ, D_MODEL), 1.0),
        'ffn1_norm': gain(ks[2], (L, D_MODEL)),
        'ffn1_w1': nrm(ks[3], (L, D_MODEL, D_FF), D_MODEL ** -0.5),
        'ffn1_w3': nrm(ks[4], (L, D_MODEL, D_FF), D_MODEL ** -0.5),
        'ffn1_w2': nrm(ks[5], (L, D_FF, D_MODEL), D_FF ** -0.5),
        'mix_norm': gain(ks[6], (L, D_MODEL)),
        'w_in': nrm(ks[7], (L, D_MODEL, N_IN), D_MODEL ** -0.5),
        'mla_q_norm': gain(ks[8], (L, Q_LORA)),
        'mla_w_uq': nrm(ks[9], (L, Q_LORA, B_HEADS * (QK_NOPE + QK_ROPE)), Q_LORA ** -0.5),
        'mla_kv_norm': gain(ks[10], (L, KV_LORA)),
        'mla_w_ukv': nrm(ks[11], (L, KV_LORA, B_HEADS * (QK_NOPE + V_DIM)), KV_LORA ** -0.5),
        'lru_conv_w': nrm(ks[12], (L, CONV_W, LRU_WIDTH), CONV_W ** -0.5),
        'lru_conv_b': nrm(ks[13], (L, LRU_WIDTH), 0.05),
        'lru_w_a': nrm(ks[14], (L, 2, LRU_BLOCKS, LRU_BLOCK, LRU_BLOCK), LRU_BLOCK ** -0.5),
        'lru_b_a': nrm(ks[15], (L, 2, LRU_WIDTH), 0.1),
        'lru_w_x': nrm(ks[16], (L, 2, LRU_BLOCKS, LRU_BLOCK, LRU_BLOCK), LRU_BLOCK ** -0.5),
        'lru_b_x': nrm(ks[17], (L, 2, LRU_WIDTH), 0.1),
        'lru_lambda': jnp.log(u) - jnp.log1p(-u),
        'sink_logits': nrm(ks[19], (L, C_HEADS), 0.5),
        'w_branch': nrm(ks[20], (L, N_BRANCH, 512, D_MODEL), 512 ** -0.5),
        'w_out': nrm(ks[21], (L, D_MODEL, D_MODEL), D_MODEL ** -0.5),
        'ffn2_norm': gain(ks[22], (L, D_MODEL)),
        'ffn2_w1': nrm(ks[23], (L, D_MODEL, D_FF), D_MODEL ** -0.5),
        'ffn2_w3': nrm(ks[24], (L, D_MODEL, D_FF), D_MODEL ** -0.5),
        'ffn2_w2': nrm(ks[25], (L, D_FF, D_MODEL), D_FF ** -0.5),
        'final_norm': gain(ks[26], (D_MODEL,)),
    }


def reference(x_prompt, x_sample, ffn1_norm, ffn1_w1, ffn1_w3, ffn1_w2, mix_norm, w_in, mla_q_norm,
              mla_w_uq, mla_kv_norm, mla_w_ukv, lru_conv_w, lru_conv_b, lru_w_a, lru_b_a, lru_w_x, lru_b_x,
              lru_lambda, sink_logits, w_branch, w_out, ffn2_norm, ffn2_w1, ffn2_w3, ffn2_w2, final_norm):
    weights = (ffn1_norm, ffn1_w1, ffn1_w3, ffn1_w2, mix_norm, w_in, mla_q_norm, mla_w_uq, mla_kv_norm,
               mla_w_ukv, lru_conv_w, lru_conv_b, lru_w_a, lru_b_a, lru_w_x, lru_b_x, lru_lambda, sink_logits,
               w_branch, w_out, ffn2_norm, ffn2_w1, ffn2_w3, ffn2_w2, final_norm)
    y_prompt = trunk(x_prompt, *weights)
    y_sample = trunk(x_sample, *weights)
    return (y_prompt, y_sample)
```

```cpp
#include <hip/hip_runtime.h>
#include <cstdio>
#include <cstdint>

#define DI __device__ __forceinline__
#define LAS __attribute__((address_space(3)))
#define GAS __attribute__((address_space(1)))

typedef unsigned short bf16_t;
typedef short bf16x8 __attribute__((ext_vector_type(8)));
typedef short s16x4 __attribute__((ext_vector_type(4)));
typedef float f32x4 __attribute__((ext_vector_type(4)));
typedef float f32x2 __attribute__((ext_vector_type(2)));
typedef float f32x16 __attribute__((ext_vector_type(16)));
typedef unsigned u32x4 __attribute__((ext_vector_type(4)));
typedef unsigned u32x2 __attribute__((ext_vector_type(2)));

typedef GAS float gf32; typedef GAS bf16_t gbf16; typedef GAS unsigned char gu8; typedef GAS f32x4 gf32x4; typedef GAS f32x2 gf32x2; typedef GAS u32x4 gu32x4; typedef GAS u32x2 gu32x2; typedef GAS bf16x8 gbf16x8;

constexpr int DM = 2048, DFF = 5632, DEPTH = 2;
constexpr int M_PROMPT = 8 * 2048, M_SAMPLE = 8 * 4096, MTOT = M_PROMPT + M_SAMPLE;
constexpr int MC = 8192;
constexpr int NCHUNK = MTOT / MC;
constexpr int N_IN = 15136;
constexpr int NPROJ = 7168, NGATE = 8192, NIN_PAD = NPROJ + NGATE;
constexpr int PC_AQ = 0, PC_AK = 1536, PC_AV = 3072, PC_CQ = 4608, PC_CKV = 4992, PC_KR = 5120, PC_C = 5376, PC_XR = 6144, PC_GT = 6656;
constexpr float EPS = 1e-6f;
constexpr float LOG2E = 1.4426950408889634f, LN2 = 0.6931471805599453f;

constexpr size_t MiB = 1u << 20;
constexpr size_t WS_CTL = 0, CTL_ZERO_BYTES = 1 * MiB;
constexpr size_t WS_ROPE = 1 * MiB;
constexpr size_t WS_SS = 2 * MiB;
constexpr size_t WS_WUP = 8 * MiB;
constexpr size_t WS_WDN = WS_WUP + 88 * MiB;
constexpr size_t WS_WIN = WS_WDN + 44 * MiB;
constexpr size_t WS_WBR = WS_WIN + 60 * MiB;
constexpr size_t WS_WOUT = WS_WBR + 8 * MiB;
constexpr size_t WS_WUQ = WS_WOUT + 8 * MiB;
constexpr size_t WS_WUKV = WS_WUQ + 1 * MiB;
constexpr size_t WS_WLRU = WS_WUKV + 1 * MiB;
constexpr size_t WS_XB = 220 * MiB;
constexpr size_t WS_BIG = 412 * MiB;
constexpr size_t WS_PROJ = WS_BIG;
constexpr size_t WS_G = WS_PROJ + 112 * MiB;
constexpr size_t WS_Y = WS_G + 128 * MiB;
constexpr size_t WS_MG = WS_Y + 32 * MiB;
constexpr size_t WS_QB = WS_MG + 32 * MiB;
constexpr size_t WS_KVB = WS_QB + 12 * MiB;
constexpr size_t WS_XC = WS_KVB + 16 * MiB;
constexpr size_t WS_AU = WS_XC + 8 * MiB;
constexpr size_t WS_OA = WS_AU + 64 * MiB;
constexpr size_t WS_LSE = WS_OA + 24 * MiB;
constexpr size_t WS_QSS = WS_LSE + 1 * MiB;
constexpr size_t WS_KSS = WS_QSS + 512 * 1024;
constexpr size_t WS_SUMF = WS_KSS + 512 * 1024;
constexpr size_t WS_SUMB = WS_SUMF + 1 * MiB;
constexpr size_t WS_CINF = WS_SUMB + 1 * MiB;
constexpr size_t WS_CINB = WS_CINF + 512 * 1024;
constexpr size_t WS_MIX_END = WS_CINB + 512 * 1024;
constexpr size_t WS_END = WS_BIG + 528 * MiB;
static_assert(WS_WLRU + 1 * MiB <= WS_XB && WS_XB + 192 * MiB <= WS_BIG && WS_MIX_END <= WS_END, "d_ws map");

constexpr int CW_BAR = 4096;

constexpr int RING_BYTES = 131072;
constexpr int LDSCTL_OFF = RING_BYTES, MISC_OFF = LDSCTL_OFF + 320;
constexpr int LDS_BYTES = 147456;
constexpr int NWAVES = 8, NTHREADS = 512;

typedef __attribute__((address_space(4))) const unsigned long long kargp_t;
DI unsigned long long ldk(int i) { kargp_t* ka = (kargp_t*)__builtin_amdgcn_kernarg_segment_ptr(); asm volatile("" : "+s"(ka)); return ka[i]; }
DI const gf32* kin(int i) { return (const gf32*)ldk(i); }
DI gf32* kout() { return (gf32*)ldk(27); }
DI gu8* kws() { return (gu8*)ldk(28); }
DI int ltid() { int t = threadIdx.x; asm volatile("" : "+v"(t)); return t; }
DI int lgrid() { int g = gridDim.x; asm volatile("" : "+s"(g)); return g; }
DI int lbid() { int b = blockIdx.x; asm volatile("" : "+s"(b)); return b; }
DI float bf2f(unsigned short b) { return __uint_as_float((unsigned)b << 16); }
DI unsigned f2bf(float f) { unsigned u = __float_as_uint(f); return (u + 0x7fffu + ((u >> 16) & 1u)) >> 16; }
DI unsigned pk2(float lo, float hi) { return f2bf(lo) | (f2bf(hi) << 16); }
DI void unpack8(const u32x4 w, float (&f)[8]) {
    f[0] = __uint_as_float(w.x << 16); f[1] = __uint_as_float(w.x & 0xffff0000u); f[2] = __uint_as_float(w.y << 16); f[3] = __uint_as_float(w.y & 0xffff0000u);
    f[4] = __uint_as_float(w.z << 16); f[5] = __uint_as_float(w.z & 0xffff0000u); f[6] = __uint_as_float(w.w << 16); f[7] = __uint_as_float(w.w & 0xffff0000u);
}
DI u32x4 pack8(const float (&o)[8]) { u32x4 w; w.x = pk2(o[0], o[1]); w.y = pk2(o[2], o[3]); w.z = pk2(o[4], o[5]); w.w = pk2(o[6], o[7]); return w; }
DI float sigmoidf_(float x) { return 1.f / (1.f + __expf(-x)); }
DI float wave_sum(float v) {
#pragma unroll
    for (int o = 1; o < 64; o <<= 1) v += __shfl_xor(v, o);
    return v;
}

namespace pg8 {
constexpr int BM = 256, BK = 64, HALF = 128, HTB = HALF * BK * 2, STAGE_BYTES = 8 * HTB, NXCD = 8, WGM = 8;
__host__ __device__ __forceinline__ int lds_byte(int r, int c) { const int st = (r >> 4) * 2 + (c >> 5), rr = r & 15, cc = c & 31, ob = rr * 64 + cc * 2; return st * 1024 + (ob ^ (((ob >> 9) & 1) << 5)); }
__host__ __device__ __forceinline__ void stage_rc(int b, int& R, int& C) { const int st = b / 1024, sb = b % 1024, swz = sb ^ (((sb >> 9) & 1) << 5); R = (st >> 1) * 16 + swz / 64; C = (st & 1) * 32 + (swz % 64) / 2; }
__host__ __device__ __forceinline__ int perm32(int rho) { const int n = rho >> 4, i = rho & 15; return 8 * (i >> 2) + 4 * n + (i & 3); }

DI void glds16s(unsigned voff, const void* sbase, unsigned lds_dst) { unsigned keep;
    asm volatile("s_mov_b32 %0, m0\n\ts_mov_b32 m0, %3\n\ts_nop 0\n\tglobal_load_lds_dwordx4 %1, %2\n\ts_mov_b32 m0, %0" : "=&s"(keep) : "v"(voff), "s"(sbase), "s"(lds_dst) : "memory"); }
struct Unit { int pm, pn; };
struct Gemm { const gbf16* A; const gbf16* Bt; int M, N, K, lda, ldb, apn_shift, apn_stride; };

struct StaticOrder {
    int nM, nN, nwg, G, c;
    DI void init(int M, int N, int G_, int c_) { nM = M / BM; nN = N / BM; nwg = nM * nN; G = G_; c = c_; }
    DI bool next(int i, Unit& u) const {
        const long L = (long)i * G + c; if (L >= nwg) return false;
        int wgid = (int)L; { const int q = nwg / NXCD, r = nwg % NXCD, xcd = wgid % NXCD, off = wgid / NXCD; wgid = (xcd < r ? xcd * (q + 1) : r * (q + 1) + (xcd - r) * q) + off; }
        const int nig = WGM * nN, gid = wgid / nig, fm = gid * WGM, gsz = (nM - fm) < WGM ? (nM - fm) : WGM;
        u.pm = fm + ((wgid % nig) % gsz); u.pn = (wgid % nig) / gsz; return true;
    }
};

template <class Epi, bool ALIGN_EPI>
DI void gemm_phase(LAS unsigned char* lds, const Gemm g, const StaticOrder& S, const Epi& E) {
    const int tid = ltid(), wid = __builtin_amdgcn_readfirstlane(tid >> 6), lane = tid & 63, wr = wid >> 2, wc = wid & 3, fr = lane & 15, fq = lane >> 4;
    const int nt = g.K / BK;
    unsigned voffA[2], voffB[2];
#pragma unroll
    for (int i = 0; i < 2; ++i) { int R, C; stage_rc(tid * 16 + i * 8192, R, C); const int Rb = Epi::PERM ? ((R & ~31) + perm32(R & 31)) : R;
        voffA[i] = (unsigned)(R * g.lda + C) * 2u; voffB[i] = (unsigned)(Rb * g.ldb + C) * 2u; }
    const size_t kstep = (size_t)(BK * 2);
    const size_t hstepA = (size_t)HALF * g.lda * 2, hstepB = (size_t)HALF * g.ldb * 2;
    const size_t tstepA = 2 * hstepA, tstepB = 2 * hstepB;
    const unsigned ldsw = (unsigned)wid * 1024u, lds32 = (unsigned)(uintptr_t)lds;
    const int aoff = lds_byte(wr * 64 + fr, fq * 8), boff = lds_byte(wc * 32 + fr, fq * 8);
#define PG8_UA(u) ((const char*)g.A + (size_t)(u).pm * tstepA + (size_t)(((u).pn >> g.apn_shift) * g.apn_stride) * 2)
#define PG8_UB(u) ((const char*)g.Bt + (size_t)(u).pn * tstepB)
#define PG8_SA(b, h) (((b) * 2 + (h)) * HTB)
#define PG8_SB(b, h) ((4 + (b) * 2 + (h)) * HTB)
#define PG8_STAGE(bufoff, gbase, voff) do { _Pragma("unroll") for (int _i = 0; _i < 2; ++_i) \
        glds16s((voff)[_i], (const void*)(gbase), lds32 + (unsigned)(bufoff) + ldsw + (unsigned)_i * 8192u); } while (0)
#define PG8_LDA(dst, b, h) do { _Pragma("unroll") for (int m = 0; m < 4; ++m) _Pragma("unroll") for (int k = 0; k < 2; ++k) dst[m][k] = *(const LAS bf16x8*)(lds + PG8_SA(b, h) + aoff + m * 2048 + k * 1024); } while (0)
#define PG8_LDB(dst, b, h) do { _Pragma("unroll") for (int n = 0; n < 2; ++n) _Pragma("unroll") for (int k = 0; k < 2; ++k) dst[n][k] = *(const LAS bf16x8*)(lds + PG8_SB(b, h) + boff + n * 2048 + k * 1024); } while (0)
#define PG8_MMA(ai, bj, At, Bt) do { __builtin_amdgcn_s_setprio(1); _Pragma("unroll") for (int m = 0; m < 4; ++m) _Pragma("unroll") for (int n = 0; n < 2; ++n) _Pragma("unroll") for (int k = 0; k < 2; ++k) \
        acc[ai][bj][m][n] = __builtin_amdgcn_mfma_f32_16x16x32_bf16(Bt[n][k], At[m][k], acc[ai][bj][m][n], 0, 0, 0); __builtin_amdgcn_s_setprio(0); } while (0)
#define PG8_WAIT_V(n) asm volatile("s_waitcnt vmcnt(" #n ")" ::: "memory")
#define PG8_WAIT_L(n) asm volatile("s_waitcnt lgkmcnt(" #n ")" ::: "memory")
#define PG8_BAR __builtin_amdgcn_s_barrier()
#define PG8_SCHED __builtin_amdgcn_sched_barrier(0)
    Unit cur, nxt; int ui = 0;
    if (!S.next(0, cur)) return;
    f32x4 acc[2][2][4][2];
#pragma unroll
    for (int a = 0; a < 2; ++a)
#pragma unroll
        for (int b = 0; b < 2; ++b)
#pragma unroll
            for (int m = 0; m < 4; ++m)
#pragma unroll
                for (int n = 0; n < 2; ++n) acc[a][b][m][n] = (f32x4){0.f, 0.f, 0.f, 0.f};
    bf16x8 At[4][2], B0[2][2], B1[2][2];
    const char* cA = PG8_UA(cur); const char* cB = PG8_UB(cur);
    PG8_STAGE(PG8_SB(0, 0), cB, voffB); PG8_STAGE(PG8_SB(0, 1), cB + hstepB, voffB); PG8_STAGE(PG8_SA(0, 0), cA, voffA); PG8_STAGE(PG8_SA(0, 1), cA + hstepA, voffA);
    if (wr == 1) PG8_BAR;
    PG8_WAIT_V(2); PG8_BAR;
    PG8_STAGE(PG8_SB(1, 0), cB + kstep, voffB); PG8_STAGE(PG8_SA(1, 0), cA + kstep, voffA); PG8_STAGE(PG8_SB(1, 1), cB + hstepB + kstep, voffB);
    PG8_WAIT_V(6); PG8_BAR;
    for (;;) {
        const bool has_next = S.next(ui + 1, nxt);
        const char* nA = has_next ? PG8_UA(nxt) : cA; const char* nB = has_next ? PG8_UB(nxt) : cB;
        for (int t = 0; t < nt; t += 2) {
            const bool last = (t == nt - 2);
            const char* a1 = cA + (size_t)(t + 1) * kstep;
            const char* a2 = last ? nA : cA + (size_t)(t + 2) * kstep; const char* b2 = last ? nB : cB + (size_t)(t + 2) * kstep;
            const char* a3 = a2 + kstep; const char* b3 = b2 + kstep;
            PG8_LDB(B0, 0, 0); PG8_LDB(B1, 0, 1); PG8_SCHED; PG8_LDA(At, 0, 0); PG8_STAGE(PG8_SA(1, 1), a1 + hstepA, voffA);
            PG8_WAIT_V(8); PG8_WAIT_L(0); PG8_BAR; PG8_MMA(0, 0, At, B0); PG8_MMA(0, 1, At, B1); PG8_BAR; PG8_SCHED;
            PG8_LDA(At, 0, 1); PG8_STAGE(PG8_SB(0, 0), b2, voffB); PG8_STAGE(PG8_SB(0, 1), b2 + hstepB, voffB); PG8_STAGE(PG8_SA(0, 0), a2, voffA);
            PG8_WAIT_V(8); PG8_WAIT_L(0); PG8_BAR; PG8_MMA(1, 0, At, B0); PG8_MMA(1, 1, At, B1); PG8_BAR; PG8_SCHED;
            PG8_LDB(B0, 1, 0); PG8_LDB(B1, 1, 1); PG8_SCHED; PG8_LDA(At, 1, 0); PG8_STAGE(PG8_SA(0, 1), a2 + hstepA, voffA);
            PG8_WAIT_V(8); PG8_WAIT_L(0); PG8_BAR; PG8_MMA(0, 0, At, B0); PG8_MMA(0, 1, At, B1); PG8_BAR; PG8_SCHED;
            PG8_LDA(At, 1, 1); PG8_STAGE(PG8_SB(1, 0), b3, voffB); PG8_STAGE(PG8_SB(1, 1), b3 + hstepB, voffB); PG8_STAGE(PG8_SA(1, 0), a3, voffA);
            PG8_WAIT_V(8); PG8_WAIT_L(0); PG8_BAR; PG8_MMA(1, 0, At, B0); PG8_MMA(1, 1, At, B1); PG8_BAR; PG8_SCHED;
            if constexpr (Epi::MID) { if (!last && ((t + 2) & 7) == 0) E.mid(acc, cur, (t + 2) >> 3, wr, wc, fr, fq); }
        }
        if constexpr (ALIGN_EPI) { if (wr == 0) PG8_BAR; }
        E(acc, cur, wr, wc, fr, fq);
        if (!has_next) break;
#pragma unroll
        for (int a = 0; a < 2; ++a)
#pragma unroll
            for (int b = 0; b < 2; ++b)
#pragma unroll
                for (int m = 0; m < 4; ++m)
#pragma unroll
                    for (int n = 0; n < 2; ++n) acc[a][b][m][n] = (f32x4){0.f, 0.f, 0.f, 0.f};
        cur = nxt; cA = nA; cB = nB; ++ui;
        if constexpr (ALIGN_EPI) { if (wr == 1) PG8_BAR; }
    }
    PG8_WAIT_V(0);
    if constexpr (!ALIGN_EPI) { if (wr == 0) PG8_BAR; }
    PG8_BAR;
#undef PG8_UA
#undef PG8_UB
#undef PG8_SA
#undef PG8_SB
#undef PG8_STAGE
#undef PG8_LDA
#undef PG8_LDB
#undef PG8_MMA
#undef PG8_WAIT_V
#undef PG8_WAIT_L
#undef PG8_BAR
#undef PG8_SCHED
}
}

namespace epi {
using pg8::Unit;
typedef const f32x4 (&AccC)[2][2][4][2];
typedef f32x4 (&AccM)[2][2][4][2];

DI void row_rstd32(const gf32* SS, int rowb, int fq, float invn, float (&rs)[2][4]) {
#pragma unroll
    for (int ai = 0; ai < 2; ++ai)
#pragma unroll
        for (int m = 0; m < 4; ++m) {
            const gf32x4* p = (const gf32x4*)(SS + (size_t)(rowb + ai * 128 + m * 16) * 32) + fq * 2;
            const f32x4 a = p[0], b = p[1];
            float s = ((a.x + a.y) + (a.z + a.w)) + ((b.x + b.y) + (b.z + b.w));
            s += __shfl_xor(s, 16); s += __shfl_xor(s, 32);
            rs[ai][m] = rsqrtf(s * invn + EPS);
        }
}
DI void rope8(float (&o)[8], const gf32* tab, int fq) {
    const f32x4 c0 = *(const gf32x4*)(tab + fq * 8), c1 = *(const gf32x4*)(tab + fq * 8 + 4);
    float a, b;
    a = o[0]; b = o[1]; o[0] = a * c0.x - b * c0.y; o[1] = a * c0.y + b * c0.x;
    a = o[2]; b = o[3]; o[2] = a * c0.z - b * c0.w; o[3] = a * c0.w + b * c0.z;
    a = o[4]; b = o[5]; o[4] = a * c1.x - b * c1.y; o[5] = a * c1.y + b * c1.x;
    a = o[6]; b = o[7]; o[6] = a * c1.z - b * c1.w; o[7] = a * c1.w + b * c1.z;
}

struct EpiSwiGLU {
    static constexpr bool PERM = true, MID = false;
    DI void operator()(AccC acc, const Unit& u, int wr, int wc, int fr, int fq) const {
        gu8* ws = kws(); gbf16* U = (gbf16*)(ws + WS_BIG); const gf32* SS = (const gf32*)(ws + WS_SS);
        const int rowb = u.pm * 256 + wr * 64 + fr; float rs[2][4]; row_rstd32(SS, rowb, fq, 1.f / (float)DM, rs);
        const int col = u.pn * 128 + wc * 32 + 8 * fq;
#pragma unroll
        for (int ai = 0; ai < 2; ++ai)
#pragma unroll
            for (int m = 0; m < 4; ++m) { const float r = rs[ai][m]; float o[8];
#pragma unroll
                for (int n = 0; n < 2; ++n)
#pragma unroll
                    for (int e = 0; e < 4; ++e) { const float a = acc[ai][0][m][n][e] * r, b = acc[ai][1][m][n][e] * r; o[4 * n + e] = a * b / (1.f + __expf(-a)); }
                *(gu32x4*)(U + (size_t)(rowb + ai * 128 + m * 16) * DFF + col) = pack8(o); }
    }
};

struct EpiResidual {
    static constexpr bool PERM = false, MID = false;
    int row0; float s;
    DI void operator()(AccC acc, const Unit& u, int wr, int wc, int fr, int fq) const {
        gu8* ws = kws(); gf32* X = kout(); gbf16* XB = (gbf16*)(ws + WS_XB); gf32* SS = (gf32*)(ws + WS_SS);
        const int rowb = row0 + u.pm * 256 + wr * 64 + fr, colb = u.pn * 256 + wc * 32 + 4 * fq;
#pragma unroll
        for (int ai = 0; ai < 2; ++ai)
#pragma unroll
            for (int m = 0; m < 4; ++m) { const int row = rowb + ai * 128 + m * 16; float ss = 0.f;
                gf32* xr = X + (size_t)row * DM + colb; gbf16* xb = XB + (size_t)row * DM + colb;
#pragma unroll
                for (int bj = 0; bj < 2; ++bj)
#pragma unroll
                    for (int n = 0; n < 2; ++n) { const int off = bj * 128 + n * 16; f32x4 x = *(const gf32x4*)(xr + off); x = x + acc[ai][bj][m][n] * s;
                        *(gf32x4*)(xr + off) = x; ss += (x.x * x.x + x.y * x.y) + (x.z * x.z + x.w * x.w);
                        u32x2 w; w.x = pk2(x.x, x.y); w.y = pk2(x.z, x.w); *(gu32x2*)(xb + off) = w; }
                ss += __shfl_xor(ss, 16); ss += __shfl_xor(ss, 32);
                if (fq == 0) SS[(size_t)row * 32 + u.pn * 4 + wc] = ss;
                asm volatile("" ::: "memory"); }
    }
};

struct EpiProj {
    static constexpr bool PERM = true, MID = false;
    int row0; int Lmask;
    DI void operator()(AccC acc, const Unit& u, int wr, int wc, int fr, int fq) const {
        gu8* ws = kws();
        const int rowb = u.pm * 256 + wr * 64 + fr; float rs[2][4]; row_rstd32((const gf32*)(ws + WS_SS) + (size_t)row0 * 32, rowb, fq, 1.f / (float)DM, rs);
        const int pn = u.pn, colin = wc * 32 + 8 * fq;
        if (pn >= 28) {
            gbf16* G = (gbf16*)(ws + WS_G);
#pragma unroll
            for (int ai = 0; ai < 2; ++ai)
#pragma unroll
                for (int m = 0; m < 4; ++m) { const int row = rowb + ai * 128 + m * 16; const float r = rs[ai][m];
#pragma unroll
                    for (int bj = 0; bj < 2; ++bj) { float o[8];
#pragma unroll
                        for (int n = 0; n < 2; ++n)
#pragma unroll
                            for (int e = 0; e < 4; ++e) o[4 * n + e] = sigmoidf_(acc[ai][bj][m][n][e] * r);
                        *(gu32x4*)(G + (size_t)row * NGATE + (pn - 28) * 256 + bj * 128 + colin) = pack8(o); } }
        } else {
            gbf16* PROJ = (gbf16*)(ws + WS_PROJ); gf32* QSS = (gf32*)(ws + WS_QSS); gf32* KSS = (gf32*)(ws + WS_KSS); const gf32* ROPE = (const gf32*)(ws + WS_ROPE);
            const float sc = (pn < 6 || pn == 21 || pn == 22) ? 0.125f * LOG2E : 1.f;
#pragma unroll
            for (int ai = 0; ai < 2; ++ai)
#pragma unroll
                for (int m = 0; m < 4; ++m) { const int row = rowb + ai * 128 + m * 16; const float r = rs[ai][m] * sc; float sq[2];
#pragma unroll
                    for (int bj = 0; bj < 2; ++bj) { float o[8]; float q = 0.f;
#pragma unroll
                        for (int n = 0; n < 2; ++n)
#pragma unroll
                            for (int e = 0; e < 4; ++e) { const float v = acc[ai][bj][m][n][e] * r; o[4 * n + e] = v; q += v * v; }
                        sq[bj] = q;
                        if (pn == 20 && bj == 0 && wc == 0) rope8(o, ROPE + (size_t)(row & Lmask) * 32, fq);
                        *(gu32x4*)(PROJ + (size_t)row * NPROJ + pn * 256 + bj * 128 + colin) = pack8(o); }
                    if (pn == 18 || pn == 19) {
                        float a = sq[0], b = sq[1];
                        a += __shfl_xor(a, 16); a += __shfl_xor(a, 32); b += __shfl_xor(b, 16); b += __shfl_xor(b, 32);
                        if (fq == 0) { if (pn == 18) QSS[(size_t)row * 8 + wc] = a + b; else { QSS[(size_t)row * 8 + 4 + wc] = a; KSS[(size_t)row * 4 + wc] = b; } }
                    } }
        }
    }
};

struct EpiMlaQ {
    static constexpr bool PERM = true, MID = false;
    int Lmask;
    DI void operator()(AccC acc, const Unit& u, int wr, int wc, int fr, int fq) const {
        gu8* ws = kws(); gbf16* QB = (gbf16*)(ws + WS_QB); const gf32* QSS = (const gf32*)(ws + WS_QSS); const gf32* ROPE = (const gf32*)(ws + WS_ROPE);
        const float scale = 0.10206207261596577f * LOG2E;
        const int rowb = u.pm * 256 + wr * 64 + fr, colin = u.pn * 256 + wc * 32 + 8 * fq;
#pragma unroll
        for (int ai = 0; ai < 2; ++ai)
#pragma unroll
            for (int m = 0; m < 4; ++m) { const int row = rowb + ai * 128 + m * 16;
                const f32x4 a = *(const gf32x4*)(QSS + (size_t)row * 8), b = *(const gf32x4*)(QSS + (size_t)row * 8 + 4);
                const float r = rsqrtf((((a.x + a.y) + (a.z + a.w)) + ((b.x + b.y) + (b.z + b.w))) * (1.f / 384.f) + EPS) * scale;
#pragma unroll
                for (int bj = 0; bj < 2; ++bj) { float o[8];
#pragma unroll
                    for (int n = 0; n < 2; ++n)
#pragma unroll
                        for (int e = 0; e < 4; ++e) o[4 * n + e] = acc[ai][bj][m][n][e] * r;
                    if (u.pn == 2) rope8(o, ROPE + (size_t)(row & Lmask) * 32, fq);
                    *(gu32x4*)(QB + (size_t)row * 768 + colin + bj * 128) = pack8(o); } }
    }
};
struct EpiMlaKV {
    static constexpr bool PERM = true, MID = false;
    DI void operator()(AccC acc, const Unit& u, int wr, int wc, int fr, int fq) const {
        gu8* ws = kws(); gbf16* KVB = (gbf16*)(ws + WS_KVB); const gf32* KSS = (const gf32*)(ws + WS_KSS);
        const int rowb = u.pm * 256 + wr * 64 + fr, colin = u.pn * 256 + wc * 32 + 8 * fq;
#pragma unroll
        for (int ai = 0; ai < 2; ++ai)
#pragma unroll
            for (int m = 0; m < 4; ++m) { const int row = rowb + ai * 128 + m * 16;
                const f32x4 a = *(const gf32x4*)(KSS + (size_t)row * 4);
                const float r = rsqrtf(((a.x + a.y) + (a.z + a.w)) * (1.f / 128.f) + EPS);
#pragma unroll
                for (int bj = 0; bj < 2; ++bj) { float o[8];
#pragma unroll
                    for (int n = 0; n < 2; ++n)
#pragma unroll
                        for (int e = 0; e < 4; ++e) o[4 * n + e] = acc[ai][bj][m][n][e] * r;
                    *(gu32x4*)(KVB + (size_t)row * 1024 + colin + bj * 128) = pack8(o); } }
    }
};
struct EpiLru {
    static constexpr bool PERM = true, MID = false;
    int layer;
    DI void operator()(AccC acc, const Unit& u, int wr, int wc, int fr, int fq) const {
        gu8* ws = kws(); gf32* AU = (gf32*)(ws + WS_AU); const gbf16* XC = (const gbf16*)(ws + WS_XC);
        const gf32* b_a = kin(15) + layer * 1024; const gf32* b_x = kin(17) + layer * 1024; const gf32* lam = kin(18) + layer * 1024;
        const int rowb = u.pm * 256 + wr * 64 + fr, ch0 = u.pn * 64 + wc * 16 + 4 * fq;
#pragma unroll
        for (int bj = 0; bj < 2; ++bj) {
            const f32x4 ba = *(const gf32x4*)(b_a + bj * 512 + ch0), bx = *(const gf32x4*)(b_x + bj * 512 + ch0), lm = *(const gf32x4*)(lam + bj * 512 + ch0);
            float sp[4];
#pragma unroll
            for (int e = 0; e < 4; ++e) sp[e] = -8.f * log1pf(__expf(-lm[e]));
#pragma unroll
            for (int ai = 0; ai < 2; ++ai)
#pragma unroll
                for (int m = 0; m < 4; ++m) { const int row = rowb + ai * 128 + m * 16;
                    const u32x2 xw = *(const gu32x2*)(XC + (size_t)row * 512 + ch0);
                    const float xc[4] = {__uint_as_float(xw.x << 16), __uint_as_float(xw.x & 0xffff0000u), __uint_as_float(xw.y << 16), __uint_as_float(xw.y & 0xffff0000u)};
                    float o[8];
#pragma unroll
                    for (int e = 0; e < 4; ++e) { const float pr = acc[ai][bj][m][e >> 1][(e & 1) * 2], pi = acc[ai][bj][m][e >> 1][(e & 1) * 2 + 1];
                        const float r = sigmoidf_(pr + ba[e]), ig = sigmoidf_(pi + bx[e]);
                        const float la = r * sp[e]; const float a1 = __expf(la); o[2 * e] = a1; o[2 * e + 1] = sqrtf(fmaxf(1.f - a1 * a1, 0.f)) * (ig * xc[e]); }
                    gf32* dst = AU + ((size_t)(row * 2 + bj) * 512 + ch0) * 2;
                    *(gf32x4*)dst = (f32x4){o[0], o[1], o[2], o[3]}; *(gf32x4*)(dst + 4) = (f32x4){o[4], o[5], o[6], o[7]};
                    asm volatile("" ::: "memory"); }
        }
    }
};
struct EpiBranch {
    static constexpr bool PERM = true, MID = true;
    DI void mid(AccM acc, const Unit& u, int b, int wr, int wc, int fr, int fq) const {
        const gbf16* G = (const gbf16*)(kws() + WS_G);
        const int rowb = u.pm * 256 + wr * 64 + fr, col = u.pn * 256 + wc * 32 + 8 * fq;
#pragma unroll
        for (int ai = 0; ai < 2; ++ai)
#pragma unroll
            for (int m = 0; m < 4; ++m) { const gbf16* gp = G + (size_t)(rowb + ai * 128 + m * 16) * NGATE + col;
#pragma unroll
                for (int bj = 0; bj < 2; ++bj) { const u32x4 w0 = *(const gu32x4*)(gp + (b - 1) * 2048 + bj * 128), w1 = *(const gu32x4*)(gp + b * 2048 + bj * 128);
                    float g0[8], g1[8]; unpack8(w0, g0); unpack8(w1, g1);
#pragma unroll
                    for (int n = 0; n < 2; ++n)
#pragma unroll
                        for (int e = 0; e < 4; ++e) acc[ai][bj][m][n][e] *= fmaxf(g0[4 * n + e], 1e-18f) * __builtin_amdgcn_rcpf(fmaxf(g1[4 * n + e], 1e-18f)); } }
    }
    DI void operator()(AccC acc, const Unit& u, int wr, int wc, int fr, int fq) const {
        gu8* ws = kws(); const gbf16* G = (const gbf16*)(ws + WS_G); gbf16* MG = (gbf16*)(ws + WS_MG);
        const int rowb = u.pm * 256 + wr * 64 + fr, col = u.pn * 256 + wc * 32 + 8 * fq;
#pragma unroll
        for (int ai = 0; ai < 2; ++ai)
#pragma unroll
            for (int m = 0; m < 4; ++m) { const int row = rowb + ai * 128 + m * 16;
#pragma unroll
                for (int bj = 0; bj < 2; ++bj) { const u32x4 w3 = *(const gu32x4*)(G + (size_t)row * NGATE + 3 * 2048 + col + bj * 128); float g3[8]; unpack8(w3, g3); float o[8];
#pragma unroll
                    for (int n = 0; n < 2; ++n)
#pragma unroll
                        for (int e = 0; e < 4; ++e) o[4 * n + e] = acc[ai][bj][m][n][e] * fmaxf(g3[4 * n + e], 1e-18f);
                    *(gu32x4*)(MG + (size_t)row * DM + col + bj * 128) = pack8(o); } }
    }
};
}

namespace att {
typedef short v4i16_t __attribute__((ext_vector_type(4)));
constexpr int KSTR64 = 144, KSTR96 = 208, VSTR = 192;
DI int crow(int r, int h) { return (r & 3) + 8 * (r >> 2) + 4 * h; }
DI s16x4 vtr(const LAS unsigned char* p) { return __builtin_bit_cast(s16x4, __builtin_amdgcn_ds_read_tr16_b64_v4i16((LAS v4i16_t*)p)); }
DI unsigned cvtpk(float lo, float hi) { typedef __bf16 bf2 __attribute__((ext_vector_type(2))); f32x2 v = {lo, hi}; bf2 b = __builtin_convertvector(v, bf2); return __builtin_bit_cast(unsigned, b); }

struct NoMask { DI float operator()(float s, int) const { return s; } };
struct BandMask {
    int kq; float slope2; int R;
    DI float operator()(float s, int koff) const { const int rel = kq + koff; const int ar = rel < 0 ? -rel : rel; return ar <= R ? s - slope2 * (float)ar : -1e30f; }
};

template <int NKS, int KSTR, class Mask>
DI void tile(const LAS unsigned char* kt, const LAS unsigned char* vt, const bf16x8 (&qf)[NKS], f32x16 (&o)[2], float& m, float& l, int lane, const Mask& mk) {
    const int r32 = lane & 31, h = lane >> 5;
    f32x16 s;
#pragma unroll
    for (int r = 0; r < 16; ++r) s[r] = 0.f;
    const LAS unsigned char* kp = kt + r32 * KSTR + h * 16;
#pragma unroll
    for (int ks = 0; ks < NKS; ++ks) { const bf16x8 kf = *(const LAS bf16x8*)(kp + ks * 32); s = __builtin_amdgcn_mfma_f32_32x32x16_bf16(kf, qf[ks], s, 0, 0, 0); }
    float tmax = -1e30f;
#pragma unroll
    for (int r = 0; r < 16; ++r) { s[r] = mk(s[r], crow(r, h)); tmax = fmaxf(tmax, s[r]); }
    tmax = fmaxf(tmax, __shfl_xor(tmax, 32));
    const float mnew = fmaxf(m, tmax);
    if (__any(mnew > m)) { const float al = __builtin_amdgcn_exp2f(m - mnew); l *= al;
#pragma unroll
        for (int r = 0; r < 16; ++r) { o[0][r] *= al; o[1][r] *= al; } }
    m = mnew;
    float p[16]; float ps = 0.f;
#pragma unroll
    for (int r = 0; r < 16; ++r) { p[r] = s[r] > -1e29f ? __builtin_amdgcn_exp2f(s[r] - mnew) : 0.f; ps += p[r]; }
    l += ps;
    bf16x8 pf[2];
#pragma unroll
    for (int st = 0; st < 2; ++st) { u32x4 w; w.x = cvtpk(p[8 * st], p[8 * st + 1]); w.y = cvtpk(p[8 * st + 2], p[8 * st + 3]); w.z = cvtpk(p[8 * st + 4], p[8 * st + 5]); w.w = cvtpk(p[8 * st + 6], p[8 * st + 7]);
        pf[st] = __builtin_bit_cast(bf16x8, w); }
    const int i16 = lane & 15, q4 = i16 >> 2, p4 = i16 & 3, g1 = (lane >> 4) & 1;
    const LAS unsigned char* vp = vt + (4 * h + q4) * VSTR + g1 * 32 + p4 * 8;
#pragma unroll
    for (int db = 0; db < 2; ++db)
#pragma unroll
        for (int st = 0; st < 2; ++st) {
            const s16x4 lo = vtr(vp + (16 * st) * VSTR + db * 64), hi = vtr(vp + (16 * st + 8) * VSTR + db * 64);
            const bf16x8 vf = (bf16x8){lo[0], lo[1], lo[2], lo[3], hi[0], hi[1], hi[2], hi[3]};
            o[db] = __builtin_amdgcn_mfma_f32_32x32x16_bf16(vf, pf[st], o[db], 0, 0, 0);
        }
}
DI void store_o(const f32x16 (&o)[2], float inv, gbf16* Orow, int h) {
#pragma unroll
    for (int db = 0; db < 2; ++db)
#pragma unroll
        for (int g4 = 0; g4 < 4; ++g4) { u32x2 w; w.x = pk2(o[db][4 * g4] * inv, o[db][4 * g4 + 1] * inv); w.y = pk2(o[db][4 * g4 + 2] * inv, o[db][4 * g4 + 3] * inv);
            *(gu32x2*)(Orow + 32 * db + 8 * g4 + 4 * h) = w; }
}

template <int R, bool SINK>
DI void banded_unit(LAS unsigned char* lds, const gbf16* Kp, const gbf16* Vp, size_t rs, int w0, int w1, bool active, const gbf16* Qp, int qw, float slope2, float sink2,
                    gbf16* Op, size_t ors, gf32* Lp, size_t lrs) {
    constexpr int VOFF = 384 * KSTR64;
    const int tid = ltid(), lane = tid & 63, r32 = lane & 31, h = lane >> 5;
    const int nrow = w1 - w0;
    for (int idx = tid; idx < nrow * 8; idx += NTHREADS) { const int i = idx >> 3, c = idx & 7;
        const u32x4 kv = *(const gu32x4*)(Kp + (size_t)(w0 + i) * rs + c * 8); const u32x4 vv = *(const gu32x4*)(Vp + (size_t)(w0 + i) * rs + c * 8);
        *(LAS u32x4*)(lds + i * KSTR64 + c * 16) = kv; *(LAS u32x4*)(lds + VOFF + i * VSTR + c * 16) = vv; }
    __syncthreads();
    if (active) {
        bf16x8 qf[4];
        const gbf16* qrow = Qp + (size_t)(qw + r32) * rs;
#pragma unroll
        for (int ks = 0; ks < 4; ++ks) qf[ks] = *(const gbf16x8*)(qrow + 16 * ks + 8 * h);
        f32x16 o[2];
#pragma unroll
        for (int r = 0; r < 16; ++r) { o[0][r] = 0.f; o[1][r] = 0.f; }
        float m = -1e30f, l = 0.f;
        int k0 = qw - R; if (k0 < w0) k0 = w0; int k1 = qw + 32 + R; if (k1 > w1) k1 = w1;
        for (int kt = k0; kt < k1; kt += 32) {
            BandMask mk; mk.kq = kt - (qw + r32); mk.slope2 = slope2; mk.R = R;
            tile<4, KSTR64, BandMask>(lds + (kt - w0) * KSTR64, lds + VOFF + (kt - w0) * VSTR, qf, o, m, l, lane, mk);
        }
        l += __shfl_xor(l, 32);
        if (SINK) l += __builtin_amdgcn_exp2f(sink2 - m);
        const float inv = 1.f / l;
        store_o(o, inv, Op + (size_t)(qw + r32) * ors, h);
        if (Lp != nullptr && h == 0) Lp[(size_t)(qw + r32) * lrs] = (m + __builtin_amdgcn_logf(l)) * LN2;
    }
    __syncthreads();
}

DI void mla_unit(LAS unsigned char* lds, const gbf16* Kn, const gbf16* Kr, const gbf16* Vp, int L, const gbf16* Qn, const gbf16* Qr, gbf16* Op) {
    constexpr int BUF = 128 * KSTR96 + 128 * VSTR, VOFF = 128 * KSTR96;
    const int tid = ltid(), lane = tid & 63, r32 = lane & 31, h = lane >> 5, wid = tid >> 6;
    bf16x8 qf[6];
    { const gbf16* qn = Qn + (size_t)(wid * 32 + r32) * 768; const gbf16* qr = Qr + (size_t)(wid * 32 + r32) * 768;
#pragma unroll
      for (int ks = 0; ks < 4; ++ks) qf[ks] = *(const gbf16x8*)(qn + 16 * ks + 8 * h);
#pragma unroll
      for (int ks = 0; ks < 2; ++ks) qf[4 + ks] = *(const gbf16x8*)(qr + 16 * ks + 8 * h); }
    f32x16 o[2];
#pragma unroll
    for (int r = 0; r < 16; ++r) { o[0][r] = 0.f; o[1][r] = 0.f; }
    float m = -1e30f, l = 0.f;
    u32x4 pre[5];
    const int ns = L / 128;
#define MLA_LOAD(st) do { _Pragma("unroll") for (int j = 0; j < 5; ++j) { const int idx = tid + NTHREADS * j, row = idx / 20, c = idx % 20; const size_t key = (size_t)(st) * 128 + row; \
        const gbf16* src = c < 8 ? Kn + key * 1024 + c * 8 : (c < 12 ? Kr + key * NPROJ + (c - 8) * 8 : Vp + key * 1024 + (c - 12) * 8); pre[j] = *(const gu32x4*)src; } } while (0)
#define MLA_WRITE(b) do { _Pragma("unroll") for (int j = 0; j < 5; ++j) { const int idx = tid + NTHREADS * j, row = idx / 20, c = idx % 20; \
        LAS unsigned char* dst = lds + (b) * BUF + (c < 12 ? row * KSTR96 + c * 16 : VOFF + row * VSTR + (c - 12) * 16); *(LAS u32x4*)dst = pre[j]; } } while (0)
    MLA_LOAD(0); MLA_WRITE(0);
    __syncthreads();
    for (int st = 0; st < ns; ++st) {
        const int b = st & 1;
        if (st + 1 < ns) MLA_LOAD(st + 1);
#pragma unroll 1
        for (int j = 0; j < 4; ++j) tile<6, KSTR96, NoMask>(lds + b * BUF + j * 32 * KSTR96, lds + b * BUF + VOFF + j * 32 * VSTR, qf, o, m, l, lane, NoMask());
        if (st + 1 < ns) MLA_WRITE(b ^ 1);
        __syncthreads();
    }
#undef MLA_LOAD
#undef MLA_WRITE
    l += __shfl_xor(l, 32);
    store_o(o, 1.f / l, Op + (size_t)(wid * 32 + r32) * DM, h);
}
}

#define XB_TMO      128
#define XB_XCNT(j)  (256  + 64 * (j))
#define XB_XSUB(j)  (1280 + 64 * (j))
#define XB_XGEN(j)  (2304 + 64 * (j))
#define XB_TOP      3328
#define XB_TOPGEN   3392
#define XCD_BAR_WORDS 3456
#define XB_SPIN_CAP (1u << 20)

DI unsigned xb_ld(unsigned* p)              { return __hip_atomic_load(p, __ATOMIC_RELAXED, __HIP_MEMORY_SCOPE_AGENT); }
DI unsigned xb_add(unsigned* p, unsigned v) { return __hip_atomic_fetch_add(p, v, __ATOMIC_RELAXED, __HIP_MEMORY_SCOPE_AGENT); }
DI unsigned xb_xcc_id() { return (unsigned)__builtin_amdgcn_s_getreg((3 << 11) | 20) & 0xFu; }
#define XB_SPIN(cond, bar) do { unsigned _sp = 0; while (cond) { __builtin_amdgcn_s_sleep(1); \
    if ((++_sp & 255u) == 0u) { if (xb_ld(&(bar)[XB_TMO])) break; if (_sp > XB_SPIN_CAP) { atomicAdd(&(bar)[XB_TMO], 1u); break; } } } } while (0)

struct XcdBarrier { unsigned* bar; unsigned x; volatile LAS unsigned* st; };

DI XcdBarrier xcd_barrier_post(unsigned* bar, volatile LAS unsigned* st) {
    XcdBarrier b; b.bar = bar; b.x = xb_xcc_id(); b.st = st;
    if (threadIdx.x == 0) (void)xb_add(&bar[XB_XCNT(b.x)], 1u);
    return b;
}
DI void xcd_barrier_complete(unsigned* bar, unsigned x, unsigned& nloc, unsigned& nx) {
    const unsigned G = gridDim.x * gridDim.y * gridDim.z;
    unsigned sum, cnt, mine, sp = 0u;
    for (;;) {
        sum = 0u; cnt = 0u; mine = 0u;
#pragma unroll
        for (unsigned j = 0; j < 16; ++j) { const unsigned c = xb_ld(&bar[XB_XCNT(j)]); sum += c; cnt += (c > 0u) ? 1u : 0u; mine = (j == x) ? c : mine; }
        if (sum == G) break;
        __builtin_amdgcn_s_sleep(1);
        if ((++sp & 255u) == 0u) { if (xb_ld(&bar[XB_TMO])) break; if (sp > XB_SPIN_CAP) { atomicAdd(&bar[XB_TMO], 1u); break; } }
    }
    nloc = mine > 0u ? mine : 1u; nx = cnt > 0u ? cnt : 1u;
}
DI void xcd_barrier(const XcdBarrier& b) {
    asm volatile("s_waitcnt vmcnt(0)" ::: "memory");
    __syncthreads();
    if (threadIdx.x == 0) {
        unsigned* bar = b.bar;
        __builtin_amdgcn_s_waitcnt(0);
        unsigned nloc = b.st[0], nx = b.st[1];
        if (nloc == 0u) { xcd_barrier_complete(bar, b.x, nloc, nx); b.st[0] = nloc; b.st[1] = nx; }
        const unsigned old = xb_add(&bar[XB_XSUB(b.x)], 1u);
        const unsigned gen = old / nloc;
        if (old + 1u == (gen + 1u) * nloc) {
            __builtin_amdgcn_fence(__ATOMIC_RELEASE, "agent");
            asm volatile("s_waitcnt vmcnt(0)" ::: "memory");
            const unsigned og = xb_add(&bar[XB_TOP], 1u);
            const unsigned tg = og / nx;
            if (og + 1u == (tg + 1u) * nx) xb_add(&bar[XB_TOPGEN], 1u);
            else XB_SPIN(xb_ld(&bar[XB_TOPGEN]) == tg, bar);
            __builtin_amdgcn_fence(__ATOMIC_ACQUIRE, "agent");
            xb_add(&bar[XB_XGEN(b.x)], 1u);
            asm volatile("s_waitcnt vmcnt(0)" ::: "memory");
        } else {
            XB_SPIN(xb_ld(&bar[XB_XGEN(b.x)]) == gen, bar);
            __builtin_amdgcn_fence(__ATOMIC_ACQUIRE, "agent");
            asm volatile("s_waitcnt vmcnt(0)" ::: "memory");
        }
    }
    __syncthreads();
}

template <class Src>
DI void conv_item(const Src src, gbf16* WT, int K, int nblk, int item, LAS float* scr, int lane) {
    const int kb = item / nblk, nb = item % nblk, k0 = 64 * kb, n0 = 32 * nb;
#pragma unroll 8
    for (int i = 0; i < 32; ++i) { const int kk = 2 * i + (lane >> 5); scr[kk * 33 + (lane & 31)] = src(k0 + kk, n0 + (lane & 31)); }
    asm volatile("s_waitcnt lgkmcnt(0)" ::: "memory");
    const int c = lane & 7;
#pragma unroll
    for (int j = 0; j < 4; ++j) { const int n = (lane >> 3) + 8 * j; const LAS float* s = scr + (8 * c) * 33 + n;
        u32x4 o; o.x = pk2(s[0 * 33], s[1 * 33]); o.y = pk2(s[2 * 33], s[3 * 33]); o.z = pk2(s[4 * 33], s[5 * 33]); o.w = pk2(s[6 * 33], s[7 * 33]);
        *(gu32x4*)(WT + (size_t)(n0 + n) * K + k0 + 8 * c) = o; }
    asm volatile("s_waitcnt lgkmcnt(0)" ::: "memory");
}
struct SrcUp { const gf32* w1; const gf32* w3; const gf32* g;
    DI float operator()(int k, int n) const { const int j = (n >> 8) * 128 + (n & 127); const uintptr_t d = (uintptr_t)w3 - (uintptr_t)w1;
        const gf32* w = (const gf32*)((uintptr_t)w1 + ((n & 128) ? d : (uintptr_t)0)); return w[(size_t)k * DFF + j] * g[k]; } };
struct SrcPlain { const gf32* w; int N;
    DI float operator()(int k, int n) const { return w[(size_t)k * N + n]; } };
struct SrcIn { const gf32* w; const gf32* g;
    DI float operator()(int k, int n) const {
        int s;
        if (n < 5120) s = n;
        else if (n < 5152) { const int j = n - 5120; s = 5120 + (j >> 1) + 16 * (j & 1); }
        else if (n < 5376) s = -1;
        else if (n < 6144) s = 5152 + (n - 5376);
        else if (n < 7168) s = 5920 + (n - 6144);
        else s = 6944 + (n - 7168);
        return s < 0 ? 0.f : w[(size_t)k * N_IN + s] * g[k]; } };
struct SrcUq { const gf32* w; const gf32* g;
    DI float operator()(int k, int n) const { int s; if (n < 512) s = (n >> 6) * 96 + (n & 63); else { const int j = n - 512, hh = j >> 5, jj = j & 31; s = hh * 96 + 64 + (jj >> 1) + 16 * (jj & 1); }
        return w[(size_t)k * 768 + s] * g[k]; } };
struct SrcUkv { const gf32* w; const gf32* g;
    DI float operator()(int k, int n) const { if (k >= 128) return 0.f; const int s = (n < 512) ? (n >> 6) * 128 + (n & 63) : ((n - 512) >> 6) * 128 + 64 + (n & 63);
        return w[(size_t)k * 1024 + s] * g[k]; } };
struct SrcLru { const gf32* wa; const gf32* wx;
    DI float operator()(int k, int n) const { const int b = n >> 8, dir = (n >> 7) & 1, e = (n & 127) >> 1, jq = k >> 6, ei = k & 63; if (jq != (b & 3)) return 0.f;
        const uintptr_t d = (uintptr_t)wx - (uintptr_t)wa; const gf32* w = (const gf32*)((uintptr_t)wa + ((n & 1) ? d : (uintptr_t)0)); return w[((size_t)(dir * 8 + b) * 64 + ei) * 64 + e]; } };
struct SrcBr { const gf32* w;
    DI float operator()(int k, int n) const { return w[(size_t)k * DM + n]; } };

#ifndef PH_P0
#define PH_P0 1
#endif
#ifndef PH_WCONV
#define PH_WCONV 1
#endif
#ifndef PH_M1
#define PH_M1 1
#endif
#ifndef PH_M2A
#define PH_M2A 1
#endif
#ifndef PH_M2B
#define PH_M2B 1
#endif
#ifndef PH_M2C
#define PH_M2C 1
#endif
#ifndef PH_M3
#define PH_M3 1
#endif
#ifndef PH_MX
#define PH_MX 1
#endif
#ifndef PH_S1
#define PH_S1 1
#endif
#ifndef PH_MY
#define PH_MY 1
#endif
#ifndef PH_S2
#define PH_S2 1
#endif
#ifndef PH_MZ
#define PH_MZ 1
#endif
#ifndef PH_S3
#define PH_S3 1
#endif
#ifndef PH_MERGE
#define PH_MERGE 1
#endif
#ifndef PH_M7
#define PH_M7 1
#endif
#ifndef PH_M8
#define PH_M8 1
#endif
#ifndef PH_UP
#define PH_UP 1
#endif
#ifndef PH_DN
#define PH_DN 1
#endif
#ifndef PH_FIN
#define PH_FIN 1
#endif
struct Params { const float* in[27]; float* out; unsigned char* ws; };

#define GRID_BAR() do { XcdBarrier bar_; bar_.bar = (unsigned*)(kws() + WS_CTL) + CW_BAR; bar_.x = xb_xcc_id(); bar_.st = (volatile LAS unsigned*)(lds + MISC_OFF) + 8; xcd_barrier(bar_); } while (0)

__global__ void __launch_bounds__(NTHREADS, 2) trunk_fwd(Params P) {
    extern __shared__ __attribute__((aligned(16))) unsigned char lds_raw[];
    LAS unsigned char* lds = (LAS unsigned char*)lds_raw;
    (void)P;
    {
        const int tid = ltid();
        for (int u = tid; u < (LDS_BYTES - LDSCTL_OFF) / 4; u += NTHREADS) ((LAS unsigned*)(lds + LDSCTL_OFF))[u] = 0u;
        __syncthreads();
        (void)xcd_barrier_post((unsigned*)(kws() + WS_CTL) + CW_BAR, (volatile LAS unsigned*)(lds + MISC_OFF) + 8);
    }

#if PH_P0
    {
        const int tid = ltid(), lane = tid & 63, wave = tid >> 6, G = lgrid(), bid = lbid();
        gu8* ws = kws(); gf32* X = kout(); gbf16* XB = (gbf16*)(ws + WS_XB); gf32* SS = (gf32*)(ws + WS_SS); gf32* ROPE = (gf32*)(ws + WS_ROPE);
        const gf32* xp = kin(0); const gf32* xs = kin(1);
        for (int i = bid * NTHREADS + tid; i < 4096 * 16; i += G * NTHREADS) { const int pos = i >> 4, j = i & 15;
            const float inv = __builtin_amdgcn_exp2f(-(float)j * (13.287712379549449f / 16.f));
            const float ang = (float)pos * inv;
            double rev = (double)ang * 0.15915494309189535; rev -= (double)(long long)rev;
            ROPE[2 * i] = __builtin_amdgcn_cosf((float)rev); ROPE[2 * i + 1] = __builtin_amdgcn_sinf((float)rev); }
        for (int r = bid * NWAVES + wave; r < MTOT; r += G * NWAVES) {
            const gf32* src = (r < M_PROMPT) ? xp + (size_t)r * DM : xs + (size_t)(r - M_PROMPT) * DM;
            const gf32x4* xr = (const gf32x4*)src + lane; f32x4 v[8]; float s = 0.f;
#pragma unroll
            for (int j = 0; j < 8; ++j) { v[j] = xr[64 * j]; s += (v[j].x * v[j].x + v[j].y * v[j].y) + (v[j].z * v[j].z + v[j].w * v[j].w); }
            s = wave_sum(s);
            gf32x4* xo = (gf32x4*)(X + (size_t)r * DM) + lane; gu32x2* bo = (gu32x2*)(XB + (size_t)r * DM) + lane;
#pragma unroll
            for (int j = 0; j < 8; ++j) { xo[64 * j] = v[j]; u32x2 w; w.x = pk2(v[j].x, v[j].y); w.y = pk2(v[j].z, v[j].w); bo[64 * j] = w; }
            if (lane < 32) SS[(size_t)r * 32 + lane] = (lane == 0) ? s : 0.f;
        }
    }
#endif

#pragma unroll 1
    for (int layer = 0; layer < DEPTH; ++layer) {
#if PH_WCONV
        {
            const int tid = ltid(), lane = tid & 63, wave = tid >> 6, G = lgrid(), bid = lbid();
            LAS float* scr = (LAS float*)(lds + wave * 16384);
            gu8* ws = kws();
            const size_t wsz = (size_t)DM * DFF;
            constexpr int I_UP = (DM / 64) * (11264 / 32), I_DN = (DFF / 64) * (DM / 32), I_IN = (DM / 64) * (NIN_PAD / 32), I_SQ = (DM / 64) * (DM / 32);
            constexpr int I_UQ = (384 / 64) * (768 / 32), I_UKV = (256 / 64) * (1024 / 32), I_LRU = (256 / 64) * (2048 / 32);
            constexpr int NITEMS = 2 * I_UP + 2 * I_DN + I_IN + 2 * I_SQ + I_UQ + I_UKV + I_LRU;
#pragma unroll 1
            for (int it = bid * NWAVES + wave; it < NITEMS; it += G * NWAVES) {
                int r = it;
                if (r < I_UP) { const SrcUp s{kin(3) + layer * wsz, kin(4) + layer * wsz, kin(2) + layer * DM}; conv_item(s, (gbf16*)(ws + WS_WUP), DM, 11264 / 32, r, scr, lane); continue; } r -= I_UP;
                if (r < I_UP) { const SrcUp s{kin(23) + layer * wsz, kin(24) + layer * wsz, kin(22) + layer * DM}; conv_item(s, (gbf16*)(ws + WS_WUP) + (size_t)11264 * DM, DM, 11264 / 32, r, scr, lane); continue; } r -= I_UP;
                if (r < I_DN) { const SrcPlain s{kin(5) + layer * wsz, DM}; conv_item(s, (gbf16*)(ws + WS_WDN), DFF, DM / 32, r, scr, lane); continue; } r -= I_DN;
                if (r < I_DN) { const SrcPlain s{kin(25) + layer * wsz, DM}; conv_item(s, (gbf16*)(ws + WS_WDN) + (size_t)DM * DFF, DFF, DM / 32, r, scr, lane); continue; } r -= I_DN;
                if (r < I_IN) { const SrcIn s{kin(7) + (size_t)layer * DM * N_IN, kin(6) + layer * DM}; conv_item(s, (gbf16*)(ws + WS_WIN), DM, NIN_PAD / 32, r, scr, lane); continue; } r -= I_IN;
                if (r < I_SQ) { const SrcBr s{kin(20) + (size_t)layer * 4 * 512 * DM}; conv_item(s, (gbf16*)(ws + WS_WBR), DM, DM / 32, r, scr, lane); continue; } r -= I_SQ;
                if (r < I_SQ) { const SrcPlain s{kin(21) + (size_t)layer * DM * DM, DM}; conv_item(s, (gbf16*)(ws + WS_WOUT), DM, DM / 32, r, scr, lane); continue; } r -= I_SQ;
                if (r < I_UQ) { const SrcUq s{kin(9) + (size_t)layer * 384 * 768, kin(8) + layer * 384}; conv_item(s, (gbf16*)(ws + WS_WUQ), 384, 768 / 32, r, scr, lane); continue; } r -= I_UQ;
                if (r < I_UKV) { const SrcUkv s{kin(11) + (size_t)layer * 128 * 1024, kin(10) + layer * 128}; conv_item(s, (gbf16*)(ws + WS_WUKV), 256, 1024 / 32, r, scr, lane); continue; } r -= I_UKV;
                { const SrcLru s{kin(14) + (size_t)layer * 2 * 8 * 64 * 64, kin(16) + (size_t)layer * 2 * 8 * 64 * 64}; conv_item(s, (gbf16*)(ws + WS_WLRU), 256, 2048 / 32, r, scr, lane); }
            }
        }
#endif
        GRID_BAR();

#pragma unroll 1
        for (int f = 0; f < 2; ++f) {
            if (f == 1) {
#pragma unroll 1
                for (int ch = 0; ch < NCHUNK; ++ch) {
                    const int row0 = ch * MC; const int L = (row0 < M_PROMPT) ? 2048 : 4096; const int nseq = MC / L;
#if PH_M1
                    {
                        gu8* ws = kws();
                        pg8::Gemm g{(const gbf16*)(ws + WS_XB) + (size_t)row0 * DM, (const gbf16*)(ws + WS_WIN), MC, NIN_PAD, DM, DM, DM, 0, 0}; pg8::StaticOrder S; S.init(MC, NIN_PAD, lgrid(), lbid());
                        epi::EpiProj E{row0, L - 1};
                        pg8::gemm_phase<epi::EpiProj, true>(lds, g, S, E);
                    }
#endif
                    GRID_BAR();
                    {
#if PH_M2A
                        {
                            const int tid = ltid(), G = lgrid(), bid = lbid();
                            gu8* ws = kws(); const gbf16* PROJ = (const gbf16*)(ws + WS_PROJ); gbf16* XC = (gbf16*)(ws + WS_XC);
                            const gf32* cw = kin(12) + layer * 4 * 512; const gf32* cb = kin(13) + layer * 512;
                            for (int idx = bid * NTHREADS + tid; idx < MC * 64; idx += G * NTHREADS) { const int row = idx >> 6, c8 = (idx & 63) * 8, pos = row & (L - 1);
                                float a[8];
                                { const f32x4 b0 = *(const gf32x4*)(cb + c8), b1 = *(const gf32x4*)(cb + c8 + 4); a[0] = b0.x; a[1] = b0.y; a[2] = b0.z; a[3] = b0.w; a[4] = b1.x; a[5] = b1.y; a[6] = b1.z; a[7] = b1.w; }
#pragma unroll
                                for (int tap = 0; tap < 4; ++tap) { const int p2 = pos + tap - 2; if (p2 >= 0 && p2 < L) {
                                    const u32x4 xw = *(const gu32x4*)(PROJ + (size_t)(row + tap - 2) * NPROJ + PC_XR + c8); float xv[8]; unpack8(xw, xv);
                                    const f32x4 w0 = *(const gf32x4*)(cw + tap * 512 + c8), w1 = *(const gf32x4*)(cw + tap * 512 + c8 + 4);
                                    a[0] += xv[0] * w0.x; a[1] += xv[1] * w0.y; a[2] += xv[2] * w0.z; a[3] += xv[3] * w0.w; a[4] += xv[4] * w1.x; a[5] += xv[5] * w1.y; a[6] += xv[6] * w1.z; a[7] += xv[7] * w1.w; } }
                                *(gu32x4*)(XC + (size_t)row * 512 + c8) = pack8(a); }
                        }
#endif
#if PH_M2B
                        {
                            gu8* ws = kws();
                            pg8::Gemm g{(const gbf16*)(ws + WS_PROJ) + PC_CQ, (const gbf16*)(ws + WS_WUQ), MC, 768, 384, NPROJ, 384, 0, 0}; pg8::StaticOrder S; S.init(MC, 768, lgrid(), lbid());
                            epi::EpiMlaQ E{L - 1};
                            pg8::gemm_phase<epi::EpiMlaQ, true>(lds, g, S, E);
                        }
#endif
#if PH_M2C
                        {
                            gu8* ws = kws();
                            pg8::Gemm g{(const gbf16*)(ws + WS_PROJ) + PC_CKV, (const gbf16*)(ws + WS_WUKV), MC, 1024, 256, NPROJ, 256, 0, 0}; pg8::StaticOrder S; S.init(MC, 1024, lgrid(), (lbid() + 160) % lgrid());
                            epi::EpiMlaKV E{};
                            pg8::gemm_phase<epi::EpiMlaKV, true>(lds, g, S, E);
                        }
#endif
                    }
                    GRID_BAR();
#if PH_M3
                    {
                        gu8* ws = kws();
                        pg8::Gemm g{(const gbf16*)(ws + WS_XC), (const gbf16*)(ws + WS_WLRU), MC, 2048, 256, 512, 256, 2, 256}; pg8::StaticOrder S; S.init(MC, 2048, lgrid(), lbid());
                        epi::EpiLru E{layer};
                        pg8::gemm_phase<epi::EpiLru, true>(lds, g, S, E);
                    }
#endif
                    GRID_BAR();
#if PH_MX
                    {
                        const int G = lgrid(), bid = lbid();
                        gu8* ws = kws(); const gbf16* PROJ = (const gbf16*)(ws + WS_PROJ); const gbf16* KVB = (const gbf16*)(ws + WS_KVB); const gbf16* QB = (const gbf16*)(ws + WS_QB); gbf16* Y = (gbf16*)(ws + WS_Y);
                        const int nqb = L / 256, nunits = nseq * 8 * nqb;
#pragma unroll 1
                        for (int ui = bid; ui < nunits; ui += G) { const int qb = ui % nqb, hd = (ui / nqb) & 7, sq = ui / (nqb * 8);
                            const size_t srow = (size_t)sq * L, qrow = srow + (size_t)qb * 256;
                            att::mla_unit(lds, KVB + srow * 1024 + hd * 64, PROJ + srow * NPROJ + PC_KR, KVB + srow * 1024 + 512 + hd * 64, L,
                                          QB + qrow * 768 + hd * 64, QB + qrow * 768 + 512 + hd * 32, Y + qrow * DM + 512 + hd * 64);
                            __syncthreads(); }
                    }
#endif
#if PH_S1
                    {
                        const int tid = ltid(), G = lgrid(), bid = lbid();
                        gu8* ws = kws(); const gf32x2* AU2 = (const gf32x2*)(ws + WS_AU); gf32x2* SUMF = (gf32x2*)(ws + WS_SUMF); gf32x2* SUMB = (gf32x2*)(ws + WS_SUMB);
                        for (int idx = bid * NTHREADS + tid; idx < (MC / 32) * 512; idx += G * NTHREADS) { const int c = idx & 511, blk = idx >> 9;
                            const gf32x2* au = AU2 + (size_t)blk * 32 * 1024 + c;
                            float Pf = 1.f, Hf = 0.f, Pb = 1.f, Hb = 0.f;
#pragma unroll 8
                            for (int t = 0; t < 32; ++t) { const f32x2 v = au[(size_t)t * 1024]; Hf = v.x * Hf + v.y; Pf *= v.x; }
#pragma unroll 8
                            for (int t = 31; t >= 0; --t) { const f32x2 v = au[(size_t)t * 1024 + 512]; Hb = v.x * Hb + v.y; Pb *= v.x; }
                            SUMF[idx] = (f32x2){Pf, Hf}; SUMB[idx] = (f32x2){Pb, Hb}; }
                    }
#endif
                    GRID_BAR();
#if PH_MY
                    {
                        const int tid = ltid(), wave = __builtin_amdgcn_readfirstlane(tid >> 6), G = lgrid(), bid = lbid();
                        gu8* ws = kws(); const gbf16* PROJ = (const gbf16*)(ws + WS_PROJ); gbf16* OA = (gbf16*)(ws + WS_OA); gf32* LSE = (gf32*)(ws + WS_LSE);
                        int ubase = 0;
#pragma unroll 1
                        for (int gi = 0; gi < 3; ++gi) {
                            const int dil = (gi == 0) ? 1 : (gi == 1 ? 4 : 16); const int Lv = L / dil; const int QBR = Lv < 256 ? Lv : 256; const int nqb = Lv / QBR, nvs = nseq * dil;
                            const int nun = 8 * nvs * nqb;
                            int first = (bid - ubase) % G; if (first < 0) first += G;
#pragma unroll 1
                            for (int ui = first; ui < nun; ui += G) { const int qb = ui % nqb, vs = (ui / nqb) % nvs, hd = ui / (nqb * nvs); const int sq = vs / dil, res = vs % dil;
                                const size_t base = (size_t)sq * L + res;
                                const int q0 = qb * QBR; int w0 = q0 - 64; if (w0 < 0) w0 = 0; int w1 = q0 + QBR + 64; if (w1 > Lv) w1 = Lv;
                                const int qw = q0 + wave * 32; const bool active = wave * 32 < QBR;
                                att::banded_unit<64, false>(lds, PROJ + base * NPROJ + PC_AK + gi * 512 + hd * 64, PROJ + base * NPROJ + PC_AV + gi * 512 + hd * 64, (size_t)dil * NPROJ, w0, w1, active,
                                                            PROJ + base * NPROJ + PC_AQ + gi * 512 + hd * 64, qw, exp2f(-(float)(hd + 1)) * (float)dil * LOG2E, 0.f,
                                                            OA + ((size_t)gi * MC + base) * 512 + hd * 64, (size_t)dil * 512, LSE + ((size_t)gi * MC + base) * 8 + hd, (size_t)dil * 8); }
                            ubase += nun;
                        }
                    }
#endif
#if PH_S2
                    {
                        const int tid = ltid(), lane = tid & 63, wave = tid >> 6, G = lgrid(), bid = lbid();
                        gu8* ws = kws();
                        const int NC = L / 32, cpl = NC / 64, nitems = nseq * 2 * 512;
                        for (int it = bid * NWAVES + wave; it < nitems; it += G * NWAVES) { const int c = it & 511, dir = (it >> 9) & 1, sq = it >> 10;
                            const gf32x2* sum = (const gf32x2*)(ws + (dir ? WS_SUMB : WS_SUMF)) + (size_t)sq * NC * 512 + c; gf32* cin = (gf32*)(ws + (dir ? WS_CINB : WS_CINF)) + (size_t)sq * NC * 512 + c;
                            const int kA = cpl * lane, tA = dir ? NC - 1 - kA : kA, tB = dir ? tA - 1 : tA + 1;
                            const f32x2 e0 = sum[(size_t)tA * 512]; f32x2 e1 = (f32x2){1.f, 0.f}; if (cpl == 2) e1 = sum[(size_t)tB * 512];
                            float Ep = e1.x * e0.x, Eh = e1.x * e0.y + e1.y;
#pragma unroll
                            for (int off = 1; off < 64; off <<= 1) { const float pp = __shfl_up(Ep, off), hp = __shfl_up(Eh, off); if (lane >= off) { Eh = Ep * hp + Eh; Ep = Ep * pp; } }
                            float xh = __shfl_up(Eh, 1); if (lane == 0) xh = 0.f;
                            cin[(size_t)tA * 512] = xh;
                            if (cpl == 2) cin[(size_t)tB * 512] = e0.x * xh + e0.y; }
                    }
#endif
                    GRID_BAR();
#if PH_MZ
                    {
                        const int tid = ltid(), wave = __builtin_amdgcn_readfirstlane(tid >> 6), G = lgrid(), bid = lbid();
                        gu8* ws = kws(); const gbf16* PROJ = (const gbf16*)(ws + WS_PROJ); gbf16* Y = (gbf16*)(ws + WS_Y);
                        const int nqb = L / 64, nunits = nseq * 2 * nqb;
                        const gf32* sink = kin(19) + layer * 8;
#pragma unroll 1
                        for (int ui = bid; ui < nunits; ui += G) { const int qb = ui % nqb, kvh = (ui / nqb) & 1, sq = ui / (nqb * 2);
                            const size_t base = (size_t)sq * L; const int q0 = qb * 64; int w0 = q0 - 128; if (w0 < 0) w0 = 0; int w1 = q0 + 64 + 128; if (w1 > L) w1 = L;
                            const int qh = kvh * 4 + (wave >> 1), qw = q0 + (wave & 1) * 32;
                            att::banded_unit<128, true>(lds, PROJ + base * NPROJ + PC_C + 512 + kvh * 64, PROJ + base * NPROJ + PC_C + 640 + kvh * 64, (size_t)NPROJ, w0, w1, true,
                                                        PROJ + base * NPROJ + PC_C + qh * 64, qw, exp2f(-(float)(qh + 1)) * LOG2E, sink[qh] * LOG2E,
                                                        Y + base * DM + 1024 + qh * 64, (size_t)DM, nullptr, 0); }
                    }
#endif
#if PH_S3
                    {
                        const int tid = ltid(), G = lgrid(), bid = lbid();
                        gu8* ws = kws(); const gbf16* PROJ = (const gbf16*)(ws + WS_PROJ); gbf16* Y = (gbf16*)(ws + WS_Y);
                        const gf32x2* AU2 = (const gf32x2*)(ws + WS_AU); const gf32* CINF = (const gf32*)(ws + WS_CINF); const gf32* CINB = (const gf32*)(ws + WS_CINB);
                        for (int idx = bid * NTHREADS + tid; idx < (MC / 32) * 512; idx += G * NTHREADS) { const int c = idx & 511, blk = idx >> 9;
                            const gf32x2* au = AU2 + (size_t)blk * 32 * 1024 + c;
                            float hf[32]; float hcur = CINF[idx];
#pragma unroll
                            for (int t = 0; t < 32; ++t) { const f32x2 v = au[(size_t)t * 1024]; hcur = v.x * hcur + v.y; hf[t] = hcur; }
                            hcur = CINB[idx];
#pragma unroll
                            for (int t = 31; t >= 0; --t) { const f32x2 v = au[(size_t)t * 1024 + 512]; hcur = v.x * hcur + v.y;
                                const size_t row = (size_t)blk * 32 + t; const float gx = bf2f(PROJ[row * NPROJ + PC_GT + c]);
                                const float ge = 0.5f * gx * (1.f + tanhf(0.7978845608028654f * (gx + 0.044715f * gx * gx * gx)));
                                Y[row * DM + 1536 + c] = (bf16_t)f2bf((hf[t] + hcur) * ge); } }
                    }
#endif
#if PH_MERGE
                    {
                        const int tid = ltid(), G = lgrid(), bid = lbid();
                        gu8* ws = kws(); gbf16* Y = (gbf16*)(ws + WS_Y); const gbf16* OA = (const gbf16*)(ws + WS_OA); const gf32* LSE = (const gf32*)(ws + WS_LSE);
                        for (int idx = bid * NTHREADS + tid; idx < MC * 64; idx += G * NTHREADS) { const int row = idx >> 6, hd = (idx >> 3) & 7, c8 = (idx & 63) * 8;
                            const float l0 = LSE[(size_t)row * 8 + hd], l1 = LSE[((size_t)MC + row) * 8 + hd], l2 = LSE[((size_t)2 * MC + row) * 8 + hd];
                            const float mx = fmaxf(l0, fmaxf(l1, l2)); float e0 = __expf(l0 - mx), e1 = __expf(l1 - mx), e2 = __expf(l2 - mx); const float inv = 1.f / (e0 + e1 + e2); e0 *= inv; e1 *= inv; e2 *= inv;
                            float a0[8], a1[8], a2[8]; unpack8(*(const gu32x4*)(OA + (size_t)row * 512 + c8), a0); unpack8(*(const gu32x4*)(OA + ((size_t)MC + row) * 512 + c8), a1); unpack8(*(const gu32x4*)(OA + ((size_t)2 * MC + row) * 512 + c8), a2);
                            float o[8];
#pragma unroll
                            for (int e = 0; e < 8; ++e) o[e] = e0 * a0[e] + e1 * a1[e] + e2 * a2[e];
                            *(gu32x4*)(Y + (size_t)row * DM + c8) = pack8(o); }
                    }
#endif
                    GRID_BAR();
#if PH_M7
                    {
                        gu8* ws = kws();
                        pg8::Gemm g{(const gbf16*)(ws + WS_Y), (const gbf16*)(ws + WS_WBR), MC, DM, DM, DM, DM, 0, 0}; pg8::StaticOrder S; S.init(MC, DM, lgrid(), lbid());
                        epi::EpiBranch E{};
                        pg8::gemm_phase<epi::EpiBranch, true>(lds, g, S, E);
                    }
#endif
                    GRID_BAR();
#if PH_M8
                    {
                        gu8* ws = kws();
                        pg8::Gemm g{(const gbf16*)(ws + WS_MG), (const gbf16*)(ws + WS_WOUT), MC, DM, DM, DM, DM, 0, 0}; pg8::StaticOrder S; S.init(MC, DM, lgrid(), lbid());
                        epi::EpiResidual E{row0, 1.0f};
                        pg8::gemm_phase<epi::EpiResidual, true>(lds, g, S, E);
                    }
#endif
                    GRID_BAR();
                }
            }
#if PH_UP
            {
                gu8* ws = kws();
                pg8::Gemm g{(const gbf16*)(ws + WS_XB), (const gbf16*)(ws + WS_WUP) + (size_t)f * 11264 * DM, MTOT, 11264, DM, DM, DM, 0, 0}; pg8::StaticOrder S; S.init(MTOT, 11264, lgrid(), lbid());
                epi::EpiSwiGLU E{};
                pg8::gemm_phase<epi::EpiSwiGLU, true>(lds, g, S, E);
            }
#endif
            GRID_BAR();
#if PH_DN
            {
                gu8* ws = kws();
                pg8::Gemm g{(const gbf16*)(ws + WS_BIG), (const gbf16*)(ws + WS_WDN) + (size_t)f * DM * DFF, MTOT, DM, DFF, DFF, DFF, 0, 0}; pg8::StaticOrder S; S.init(MTOT, DM, lgrid(), lbid());
                epi::EpiResidual E{0, 0.5f};
                pg8::gemm_phase<epi::EpiResidual, true>(lds, g, S, E);
            }
#endif
            GRID_BAR();
        }
    }
#if PH_FIN
    {
        const int tid = ltid(), lane = tid & 63, wave = tid >> 6, G = lgrid(), bid = lbid();
        gu8* ws = kws(); gf32* X = kout(); const gf32* SS = (const gf32*)(ws + WS_SS);
        const gf32* gn = kin(26);
        const unsigned tmo = __hip_atomic_load((unsigned*)(ws + WS_CTL) + CW_BAR + XB_TMO, __ATOMIC_RELAXED, __HIP_MEMORY_SCOPE_AGENT);
        for (int r = bid * NWAVES + wave; r < MTOT; r += G * NWAVES) {
            float s = (lane < 32) ? SS[(size_t)r * 32 + lane] : 0.f; s = wave_sum(s);
            float rstd = rsqrtf(s * (1.f / (float)DM) + EPS); if (tmo != 0u) rstd = __builtin_nanf("");
            gf32x4* xo = (gf32x4*)(X + (size_t)r * DM) + lane; const gf32x4* gp = (const gf32x4*)gn + lane;
#pragma unroll
            for (int j = 0; j < 8; ++j) { const f32x4 v = xo[64 * j], gg = gp[64 * j]; xo[64 * j] = v * rstd * gg; }
        }
    }
#endif
}

extern "C" void kernel_launch(void* const* d_in, const int* in_sizes, int n_in, void* d_out, int out_size, void* d_ws, size_t ws_size, hipStream_t stream) {
    static int grid = 0;
    if (grid == 0) {
        if (n_in != 27 || out_size != MTOT * DM || ws_size < WS_END) { fprintf(stderr, "kernel_launch: unexpected problem (n_in %d, out %d, ws %zu, need %zu); nothing launched\n", n_in, out_size, ws_size, (size_t)WS_END); grid = -1; return; }
        int dev = 0, cus = 0, per_cu = 0;
        if (hipGetDevice(&dev) != hipSuccess || hipDeviceGetAttribute(&cus, hipDeviceAttributeMultiprocessorCount, dev) != hipSuccess) { grid = -1; return; }
        if (hipFuncSetAttribute((const void*)trunk_fwd, hipFuncAttributeMaxDynamicSharedMemorySize, LDS_BYTES) != hipSuccess) { fprintf(stderr, "kernel_launch: hipFuncSetAttribute failed\n"); grid = -1; return; }
        if (hipOccupancyMaxActiveBlocksPerMultiprocessor(&per_cu, (const void*)trunk_fwd, NTHREADS, LDS_BYTES) != hipSuccess || per_cu < 1) { fprintf(stderr, "kernel_launch: occupancy query reports %d\n", per_cu); }
        (void)hipGetLastError();
        grid = cus;
    }
    if (grid < 0) return;
    (void)in_sizes;
    if (hipMemsetAsync((char*)d_ws + WS_CTL, 0, CTL_ZERO_BYTES, stream) != hipSuccess) return;
    Params p{};
    for (int i = 0; i < 27; ++i) p.in[i] = (const float*)d_in[i];
    p.out = (float*)d_out; p.ws = (unsigned char*)d_ws;
    hipLaunchKernelGGL(trunk_fwd, dim3(grid), dim3(NTHREADS), LDS_BYTES, stream, p);
}
```

```cpp
#include <hip/hip_runtime.h>
#include <cstdio>
#include <cstdint>

#define DI __device__ __forceinline__
#define LAS __attribute__((address_space(3)))
#define GAS __attribute__((address_space(1)))

typedef unsigned short bf16_t;
typedef short bf16x8 __attribute__((ext_vector_type(8)));
typedef short s16x4 __attribute__((ext_vector_type(4)));
typedef float f32x4 __attribute__((ext_vector_type(4)));
typedef float f32x2 __attribute__((ext_vector_type(2)));
typedef float f32x16 __attribute__((ext_vector_type(16)));
typedef unsigned u32x4 __attribute__((ext_vector_type(4)));
typedef unsigned u32x2 __attribute__((ext_vector_type(2)));

typedef GAS float gf32; typedef GAS bf16_t gbf16; typedef GAS unsigned char gu8; typedef GAS f32x4 gf32x4; typedef GAS f32x2 gf32x2; typedef GAS u32x4 gu32x4; typedef GAS u32x2 gu32x2; typedef GAS bf16x8 gbf16x8;

constexpr int DM = 2048, DFF = 5632, DEPTH = 2;
constexpr int M_PROMPT = 8 * 2048, M_SAMPLE = 8 * 4096, MTOT = M_PROMPT + M_SAMPLE;
constexpr int MC = 16384;
constexpr int NCHUNK = MTOT / MC;
constexpr int N_IN = 15136;
constexpr int NPROJ = 7168, NGATE = 8192, NIN_PAD = NPROJ + NGATE;
constexpr int PC_AQ = 0, PC_AK = 1536, PC_AV = 3072, PC_CQ = 4608, PC_CKV = 4992, PC_KR = 5120, PC_C = 5376, PC_XR = 6144, PC_GT = 6656;
constexpr float EPS = 1e-6f;
constexpr float LOG2E = 1.4426950408889634f, LN2 = 0.6931471805599453f;

constexpr size_t MiB = 1u << 20;
constexpr size_t WS_CTL = 0, CTL_ZERO_BYTES = 1 * MiB;
constexpr size_t WS_ROPE = 1 * MiB;
constexpr size_t WS_SS = 2 * MiB;
constexpr size_t WS_WUP = 8 * MiB;
constexpr size_t WS_WDN = WS_WUP + 88 * MiB;
constexpr size_t WS_WIN = WS_WDN + 44 * MiB;
constexpr size_t WS_WBR = WS_WIN + 60 * MiB;
constexpr size_t WS_WOUT = WS_WBR + 8 * MiB;
constexpr size_t WS_WUQ = WS_WOUT + 8 * MiB;
constexpr size_t WS_WUKV = WS_WUQ + 1 * MiB;
constexpr size_t WS_WLRU = WS_WUKV + 1 * MiB;
constexpr size_t WS_XB = 220 * MiB;
constexpr size_t WS_BIG = 412 * MiB;
constexpr size_t WS_PROJ = WS_BIG;
constexpr size_t WS_MG = WS_PROJ;
constexpr size_t WS_G = WS_PROJ + 224 * MiB;
constexpr size_t WS_Y = WS_G + 256 * MiB;
constexpr size_t WS_XC = WS_Y;
constexpr size_t WS_QB = WS_Y + 64 * MiB;
constexpr size_t WS_KVB = WS_QB + 24 * MiB;
constexpr size_t WS_AU = WS_KVB + 32 * MiB;
constexpr size_t WS_OA = WS_AU + 128 * MiB;
constexpr size_t WS_LSE = WS_OA + 48 * MiB;
constexpr size_t WS_QSS = WS_LSE + 2 * MiB;
constexpr size_t WS_KSS = WS_QSS + 512 * 1024;
constexpr size_t WS_SUMF = WS_KSS + 512 * 1024;
constexpr size_t WS_SUMB = WS_SUMF + 2 * MiB;
constexpr size_t WS_MIX_END = WS_SUMB + 2 * MiB;
constexpr size_t WS_END = WS_MIX_END;
static_assert(WS_WLRU + 1 * MiB <= WS_XB && WS_XB + 192 * MiB <= WS_BIG && WS_BIG + 528 * MiB <= WS_MIX_END && WS_END <= 1216 * MiB, "d_ws map");

constexpr int CW_BAR = 4096;

constexpr int RING_BYTES = 131072;
constexpr int LDSCTL_OFF = RING_BYTES, MISC_OFF = LDSCTL_OFF + 320;
constexpr int LDS_BYTES = 147456;
constexpr int NWAVES = 8, NTHREADS = 512;

typedef __attribute__((address_space(4))) const unsigned long long kargp_t;
DI unsigned long long ldk(int i) { kargp_t* ka = (kargp_t*)__builtin_amdgcn_kernarg_segment_ptr(); asm volatile("" : "+s"(ka)); return ka[i]; }
DI const gf32* kin(int i) { return (const gf32*)ldk(i); }
DI gf32* kout() { return (gf32*)ldk(27); }
DI gu8* kws() { return (gu8*)ldk(28); }
DI int ltid() { int t = threadIdx.x; asm volatile("" : "+v"(t)); return t; }
DI int lgrid() { int g = gridDim.x; asm volatile("" : "+s"(g)); return g; }
DI int lbid() { int b = blockIdx.x; asm volatile("" : "+s"(b)); return b; }
DI float bf2f(unsigned short b) { return __uint_as_float((unsigned)b << 16); }
DI unsigned f2bf(float f) { unsigned u = __float_as_uint(f); return (u + 0x7fffu + ((u >> 16) & 1u)) >> 16; }
DI unsigned pk2(float lo, float hi) { return f2bf(lo) | (f2bf(hi) << 16); }
DI void unpack8(const u32x4 w, float (&f)[8]) {
    f[0] = __uint_as_float(w.x << 16); f[1] = __uint_as_float(w.x & 0xffff0000u); f[2] = __uint_as_float(w.y << 16); f[3] = __uint_as_float(w.y & 0xffff0000u);
    f[4] = __uint_as_float(w.z << 16); f[5] = __uint_as_float(w.z & 0xffff0000u); f[6] = __uint_as_float(w.w << 16); f[7] = __uint_as_float(w.w & 0xffff0000u);
}
DI u32x4 pack8(const float (&o)[8]) { u32x4 w; w.x = pk2(o[0], o[1]); w.y = pk2(o[2], o[3]); w.z = pk2(o[4], o[5]); w.w = pk2(o[6], o[7]); return w; }
DI float sigmoidf_(float x) { return __builtin_amdgcn_rcpf(1.f + __builtin_amdgcn_exp2f(x * -LOG2E)); }
DI float wave_sum(float v) {
#pragma unroll
    for (int o = 1; o < 64; o <<= 1) v += __shfl_xor(v, o);
    return v;
}

namespace pg8 {
constexpr int BM = 256, BK = 64, HALF = 128, HTB = HALF * BK * 2, STAGE_BYTES = 8 * HTB, NXCD = 8, WGM = 8;
__host__ __device__ __forceinline__ int lds_byte(int r, int c) { const int st = (r >> 4) * 2 + (c >> 5), rr = r & 15, cc = c & 31, ob = rr * 64 + cc * 2; return st * 1024 + (ob ^ (((ob >> 9) & 1) << 5)); }
__host__ __device__ __forceinline__ void stage_rc(int b, int& R, int& C) { const int st = b / 1024, sb = b % 1024, swz = sb ^ (((sb >> 9) & 1) << 5); R = (st >> 1) * 16 + swz / 64; C = (st & 1) * 32 + (swz % 64) / 2; }
__host__ __device__ __forceinline__ int perm32(int rho) { const int n = rho >> 4, i = rho & 15; return 8 * (i >> 2) + 4 * n + (i & 3); }

DI void glds16s(unsigned voff, const void* sbase, unsigned lds_dst) { unsigned keep;
    asm volatile("s_mov_b32 %0, m0\n\ts_mov_b32 m0, %3\n\ts_nop 0\n\tglobal_load_lds_dwordx4 %1, %2\n\ts_mov_b32 m0, %0" : "=&s"(keep) : "v"(voff), "s"(sbase), "s"(lds_dst) : "memory"); }
struct Unit { int pm, pn; };
struct Gemm { const gbf16* A; const gbf16* Bt; int M, N, K, lda, ldb, apn_shift, apn_stride; };

struct StaticOrder {
    int nM, nN, nwg, G, c, pn0, skip_from, skip_by;
    DI void init(int M, int N, int G_, int c_, int pn0_ = 0, int skip_from_ = 1 << 30, int skip_by_ = 0) { nM = M / BM; nN = N / BM; nwg = nM * nN; G = G_; c = c_; pn0 = pn0_; skip_from = skip_from_; skip_by = skip_by_; }
    DI bool next(int i, Unit& u) const {
        const long L = (long)i * G + c; if (L >= nwg) return false;
        int wgid = (int)L; { const int q = nwg / NXCD, r = nwg % NXCD, xcd = wgid % NXCD, off = wgid / NXCD; wgid = (xcd < r ? xcd * (q + 1) : r * (q + 1) + (xcd - r) * q) + off; }
        const int nig = WGM * nN, gid = wgid / nig, fm = gid * WGM, gsz = (nM - fm) < WGM ? (nM - fm) : WGM;
        u.pm = fm + ((wgid % nig) % gsz); int pn = pn0 + (wgid % nig) / gsz; if (pn >= skip_from) pn += skip_by; u.pn = pn; return true;
    }
};

template <class Epi, bool ALIGN_EPI>
DI void gemm_phase(LAS unsigned char* lds, const Gemm g, const StaticOrder& S, const Epi& E) {
    const int tid = ltid(), wid = __builtin_amdgcn_readfirstlane(tid >> 6), lane = tid & 63, wr = wid >> 2, wc = wid & 3, fr = lane & 15, fq = lane >> 4;
    const int nt = g.K / BK;
    unsigned voffA[2], voffB[2];
#pragma unroll
    for (int i = 0; i < 2; ++i) { int R, C; stage_rc(tid * 16 + i * 8192, R, C); const int Rb = Epi::PERM ? ((R & ~31) + perm32(R & 31)) : R;
        voffA[i] = (unsigned)(R * g.lda + C) * 2u; voffB[i] = (unsigned)(Rb * g.ldb + C) * 2u; }
    const size_t kstep = (size_t)(BK * 2);
    const size_t hstepA = (size_t)HALF * g.lda * 2, hstepB = (size_t)HALF * g.ldb * 2;
    const size_t tstepA = 2 * hstepA, tstepB = 2 * hstepB;
    const unsigned ldsw = (unsigned)wid * 1024u, lds32 = (unsigned)(uintptr_t)lds;
    const int aoff = lds_byte(wr * 64 + fr, fq * 8), boff = lds_byte(wc * 32 + fr, fq * 8);
#define PG8_UA(u) ((const char*)g.A + (size_t)(u).pm * tstepA + (size_t)(((u).pn >> g.apn_shift) * g.apn_stride) * 2)
#define PG8_UB(u) ((const char*)g.Bt + (size_t)(u).pn * tstepB)
#define PG8_SA(b, h) (((b) * 2 + (h)) * HTB)
#define PG8_SB(b, h) ((4 + (b) * 2 + (h)) * HTB)
#define PG8_STAGE(bufoff, gbase, voff) do { _Pragma("unroll") for (int _i = 0; _i < 2; ++_i) \
        glds16s((voff)[_i], (const void*)(gbase), lds32 + (unsigned)(bufoff) + ldsw + (unsigned)_i * 8192u); } while (0)
#define PG8_LDA(dst, b, h) do { _Pragma("unroll") for (int m = 0; m < 4; ++m) _Pragma("unroll") for (int k = 0; k < 2; ++k) dst[m][k] = *(const LAS bf16x8*)(lds + PG8_SA(b, h) + aoff + m * 2048 + k * 1024); } while (0)
#define PG8_LDB(dst, b, h) do { _Pragma("unroll") for (int n = 0; n < 2; ++n) _Pragma("unroll") for (int k = 0; k < 2; ++k) dst[n][k] = *(const LAS bf16x8*)(lds + PG8_SB(b, h) + boff + n * 2048 + k * 1024); } while (0)
#define PG8_MMA(ai, bj, At, Bt) do { __builtin_amdgcn_s_setprio(1); _Pragma("unroll") for (int m = 0; m < 4; ++m) _Pragma("unroll") for (int n = 0; n < 2; ++n) _Pragma("unroll") for (int k = 0; k < 2; ++k) \
        acc[ai][bj][m][n] = __builtin_amdgcn_mfma_f32_16x16x32_bf16(Bt[n][k], At[m][k], acc[ai][bj][m][n], 0, 0, 0); __builtin_amdgcn_s_setprio(0); } while (0)
#define PG8_WAIT_V(n) asm volatile("s_waitcnt vmcnt(" #n ")" ::: "memory")
#define PG8_WAIT_L(n) asm volatile("s_waitcnt lgkmcnt(" #n ")" ::: "memory")
#define PG8_BAR __builtin_amdgcn_s_barrier()
#define PG8_SCHED __builtin_amdgcn_sched_barrier(0)
    Unit cur, nxt; int ui = 0;
    if (!S.next(0, cur)) return;
    f32x4 acc[2][2][4][2];
#pragma unroll
    for (int a = 0; a < 2; ++a)
#pragma unroll
        for (int b = 0; b < 2; ++b)
#pragma unroll
            for (int m = 0; m < 4; ++m)
#pragma unroll
                for (int n = 0; n < 2; ++n) acc[a][b][m][n] = (f32x4){0.f, 0.f, 0.f, 0.f};
    bf16x8 At[4][2], B0[2][2], B1[2][2];
    const char* cA = PG8_UA(cur); const char* cB = PG8_UB(cur);
    PG8_STAGE(PG8_SB(0, 0), cB, voffB); PG8_STAGE(PG8_SB(0, 1), cB + hstepB, voffB); PG8_STAGE(PG8_SA(0, 0), cA, voffA); PG8_STAGE(PG8_SA(0, 1), cA + hstepA, voffA);
    if (wr == 1) PG8_BAR;
    PG8_WAIT_V(2); PG8_BAR;
    PG8_STAGE(PG8_SB(1, 0), cB + kstep, voffB); PG8_STAGE(PG8_SA(1, 0), cA + kstep, voffA); PG8_STAGE(PG8_SB(1, 1), cB + hstepB + kstep, voffB);
    PG8_WAIT_V(6); PG8_BAR;
    for (;;) {
        const bool has_next = S.next(ui + 1, nxt);
        const char* nA = has_next ? PG8_UA(nxt) : cA; const char* nB = has_next ? PG8_UB(nxt) : cB;
        for (int t = 0; t < nt; t += 2) {
            const bool last = (t == nt - 2);
            const char* a1 = cA + (size_t)(t + 1) * kstep;
            const char* a2 = last ? nA : cA + (size_t)(t + 2) * kstep; const char* b2 = last ? nB : cB + (size_t)(t + 2) * kstep;
            const char* a3 = a2 + kstep; const char* b3 = b2 + kstep;
            PG8_LDB(B0, 0, 0); PG8_LDB(B1, 0, 1); PG8_SCHED; PG8_LDA(At, 0, 0); PG8_STAGE(PG8_SA(1, 1), a1 + hstepA, voffA);
            PG8_WAIT_V(8); PG8_WAIT_L(0); PG8_BAR; PG8_MMA(0, 0, At, B0); PG8_MMA(0, 1, At, B1); PG8_BAR; PG8_SCHED;
            PG8_LDA(At, 0, 1); PG8_STAGE(PG8_SB(0, 0), b2, voffB); PG8_STAGE(PG8_SB(0, 1), b2 + hstepB, voffB); PG8_STAGE(PG8_SA(0, 0), a2, voffA);
            PG8_WAIT_V(8); PG8_WAIT_L(0); PG8_BAR; PG8_MMA(1, 0, At, B0); PG8_MMA(1, 1, At, B1); PG8_BAR; PG8_SCHED;
            PG8_LDB(B0, 1, 0); PG8_LDB(B1, 1, 1); PG8_SCHED; PG8_LDA(At, 1, 0); PG8_STAGE(PG8_SA(0, 1), a2 + hstepA, voffA);
            PG8_WAIT_V(8); PG8_WAIT_L(0); PG8_BAR; PG8_MMA(0, 0, At, B0); PG8_MMA(0, 1, At, B1); PG8_BAR; PG8_SCHED;
            PG8_LDA(At, 1, 1); PG8_STAGE(PG8_SB(1, 0), b3, voffB); PG8_STAGE(PG8_SB(1, 1), b3 + hstepB, voffB); PG8_STAGE(PG8_SA(1, 0), a3, voffA);
            PG8_WAIT_V(8); PG8_WAIT_L(0); PG8_BAR; PG8_MMA(1, 0, At, B0); PG8_MMA(1, 1, At, B1); PG8_BAR; PG8_SCHED;
            if constexpr (Epi::MID) { if (!last && ((t + 2) & 7) == 0) E.mid(acc, cur, (t + 2) >> 3, wr, wc, fr, fq); }
        }
        if constexpr (ALIGN_EPI) { if (wr == 0) PG8_BAR; }
        E(acc, cur, wr, wc, fr, fq);
        if (!has_next) break;
#pragma unroll
        for (int a = 0; a < 2; ++a)
#pragma unroll
            for (int b = 0; b < 2; ++b)
#pragma unroll
                for (int m = 0; m < 4; ++m)
#pragma unroll
                    for (int n = 0; n < 2; ++n) acc[a][b][m][n] = (f32x4){0.f, 0.f, 0.f, 0.f};
        cur = nxt; cA = nA; cB = nB; ++ui;
        if constexpr (ALIGN_EPI) { if (wr == 1) PG8_BAR; }
    }
    PG8_WAIT_V(0);
    if constexpr (!ALIGN_EPI) { if (wr == 0) PG8_BAR; }
    PG8_BAR;
#undef PG8_UA
#undef PG8_UB
#undef PG8_SA
#undef PG8_SB
#undef PG8_STAGE
#undef PG8_LDA
#undef PG8_LDB
#undef PG8_MMA
#undef PG8_WAIT_V
#undef PG8_WAIT_L
#undef PG8_BAR
#undef PG8_SCHED
}
}

namespace epi {
using pg8::Unit;
typedef const f32x4 (&AccC)[2][2][4][2];
typedef f32x4 (&AccM)[2][2][4][2];

DI void row_rstd32(const gf32* SS, int rowb, int fq, float invn, float (&rs)[2][4]) {
#pragma unroll
    for (int ai = 0; ai < 2; ++ai)
#pragma unroll
        for (int m = 0; m < 4; ++m) {
            const gf32x4* p = (const gf32x4*)(SS + (size_t)(rowb + ai * 128 + m * 16) * 32) + fq * 2;
            const f32x4 a = p[0], b = p[1];
            float s = ((a.x + a.y) + (a.z + a.w)) + ((b.x + b.y) + (b.z + b.w));
            s += __shfl_xor(s, 16); s += __shfl_xor(s, 32);
            rs[ai][m] = rsqrtf(s * invn + EPS);
        }
}
DI void rope8(float (&o)[8], const gf32* tab, int fq) {
    const f32x4 c0 = *(const gf32x4*)(tab + fq * 8), c1 = *(const gf32x4*)(tab + fq * 8 + 4);
    float a, b;
    a = o[0]; b = o[1]; o[0] = a * c0.x - b * c0.y; o[1] = a * c0.y + b * c0.x;
    a = o[2]; b = o[3]; o[2] = a * c0.z - b * c0.w; o[3] = a * c0.w + b * c0.z;
    a = o[4]; b = o[5]; o[4] = a * c1.x - b * c1.y; o[5] = a * c1.y + b * c1.x;
    a = o[6]; b = o[7]; o[6] = a * c1.z - b * c1.w; o[7] = a * c1.w + b * c1.z;
}

struct EpiSwiGLU {
    static constexpr bool PERM = true, MID = false;
    DI void operator()(AccC acc, const Unit& u, int wr, int wc, int fr, int fq) const {
        gu8* ws = kws(); gbf16* U = (gbf16*)(ws + WS_BIG); const gf32* SS = (const gf32*)(ws + WS_SS);
        const int rowb = u.pm * 256 + wr * 64 + fr; float rs[2][4]; row_rstd32(SS, rowb, fq, 1.f / (float)DM, rs);
        const int col = u.pn * 128 + wc * 32 + 8 * fq;
#pragma unroll
        for (int ai = 0; ai < 2; ++ai)
#pragma unroll
            for (int m = 0; m < 4; ++m) { const float r = rs[ai][m]; float o[8];
#pragma unroll
                for (int n = 0; n < 2; ++n)
#pragma unroll
                    for (int e = 0; e < 4; ++e) { const float a = acc[ai][0][m][n][e] * r, b = acc[ai][1][m][n][e] * r; o[4 * n + e] = a * b * __builtin_amdgcn_rcpf(1.f + __builtin_amdgcn_exp2f(a * -LOG2E)); }
                *(gu32x4*)(U + (size_t)(rowb + ai * 128 + m * 16) * DFF + col) = pack8(o); }
    }
};

struct EpiResidual {
    static constexpr bool PERM = false, MID = false;
    int row0; float s;
    DI void operator()(AccC acc, const Unit& u, int wr, int wc, int fr, int fq) const {
        gu8* ws = kws(); gf32* X = kout(); gbf16* XB = (gbf16*)(ws + WS_XB); gf32* SS = (gf32*)(ws + WS_SS);
        const int rowb = row0 + u.pm * 256 + wr * 64 + fr, colb = u.pn * 256 + wc * 32 + 4 * fq;
#pragma unroll
        for (int ai = 0; ai < 2; ++ai)
#pragma unroll
            for (int m = 0; m < 4; ++m) { const int row = rowb + ai * 128 + m * 16; float ss = 0.f;
                gf32* xr = X + (size_t)row * DM + colb; gbf16* xb = XB + (size_t)row * DM + colb;
#pragma unroll
                for (int bj = 0; bj < 2; ++bj)
#pragma unroll
                    for (int n = 0; n < 2; ++n) { const int off = bj * 128 + n * 16; f32x4 x = *(const gf32x4*)(xr + off); x = x + acc[ai][bj][m][n] * s;
                        *(gf32x4*)(xr + off) = x; ss += (x.x * x.x + x.y * x.y) + (x.z * x.z + x.w * x.w);
                        u32x2 w; w.x = pk2(x.x, x.y); w.y = pk2(x.z, x.w); *(gu32x2*)(xb + off) = w; }
                ss += __shfl_xor(ss, 16); ss += __shfl_xor(ss, 32);
                if (fq == 0) SS[(size_t)row * 32 + u.pn * 4 + wc] = ss;
                asm volatile("" ::: "memory"); }
    }
};

struct EpiProj {
    static constexpr bool PERM = true, MID = false;
    int row0; int Lmask;
    DI void operator()(AccC acc, const Unit& u, int wr, int wc, int fr, int fq) const {
        gu8* ws = kws();
        const int rowb = u.pm * 256 + wr * 64 + fr; float rs[2][4]; row_rstd32((const gf32*)(ws + WS_SS) + (size_t)row0 * 32, rowb, fq, 1.f / (float)DM, rs);
        const int pn = u.pn, colin = wc * 32 + 8 * fq;
        if (pn >= 28) {
            gbf16* G = (gbf16*)(ws + WS_G);
#pragma unroll
            for (int ai = 0; ai < 2; ++ai)
#pragma unroll
                for (int m = 0; m < 4; ++m) { const int row = rowb + ai * 128 + m * 16; const float r = rs[ai][m];
#pragma unroll
                    for (int bj = 0; bj < 2; ++bj) { float o[8];
#pragma unroll
                        for (int n = 0; n < 2; ++n)
#pragma unroll
                            for (int e = 0; e < 4; ++e) o[4 * n + e] = sigmoidf_(acc[ai][bj][m][n][e] * r);
                        *(gu32x4*)(G + (size_t)row * NGATE + (pn - 28) * 256 + bj * 128 + colin) = pack8(o); } }
        } else {
            gbf16* PROJ = (gbf16*)(ws + WS_PROJ); gf32* QSS = (gf32*)(ws + WS_QSS); gf32* KSS = (gf32*)(ws + WS_KSS); const gf32* ROPE = (const gf32*)(ws + WS_ROPE);
            const float sc = (pn < 6 || pn == 21 || pn == 22) ? 0.125f * LOG2E : 1.f;
#pragma unroll
            for (int ai = 0; ai < 2; ++ai)
#pragma unroll
                for (int m = 0; m < 4; ++m) { const int row = rowb + ai * 128 + m * 16; const float r = rs[ai][m] * sc; float sq[2];
#pragma unroll
                    for (int bj = 0; bj < 2; ++bj) { float o[8]; float q = 0.f;
#pragma unroll
                        for (int n = 0; n < 2; ++n)
#pragma unroll
                            for (int e = 0; e < 4; ++e) { const float v = acc[ai][bj][m][n][e] * r; o[4 * n + e] = v; q += v * v; }
                        sq[bj] = q;
                        if (pn == 20 && bj == 0 && wc == 0) rope8(o, ROPE + (size_t)(row & Lmask) * 32, fq);
                        *(gu32x4*)(PROJ + (size_t)row * NPROJ + pn * 256 + bj * 128 + colin) = pack8(o); }
                    if (pn == 18 || pn == 19) {
                        float a = sq[0], b = sq[1];
                        a += __shfl_xor(a, 16); a += __shfl_xor(a, 32); b += __shfl_xor(b, 16); b += __shfl_xor(b, 32);
                        if (fq == 0) { if (pn == 18) QSS[(size_t)row * 8 + wc] = a + b; else { QSS[(size_t)row * 8 + 4 + wc] = a; KSS[(size_t)row * 4 + wc] = b; } }
                    } }
        }
    }
};

struct EpiMlaQ {
    static constexpr bool PERM = true, MID = false;
    int Lmask;
    DI void operator()(AccC acc, const Unit& u, int wr, int wc, int fr, int fq) const {
        gu8* ws = kws(); gbf16* QB = (gbf16*)(ws + WS_QB); const gf32* QSS = (const gf32*)(ws + WS_QSS); const gf32* ROPE = (const gf32*)(ws + WS_ROPE);
        const float scale = 0.10206207261596577f * LOG2E;
        const int rowb = u.pm * 256 + wr * 64 + fr, colin = u.pn * 256 + wc * 32 + 8 * fq;
#pragma unroll
        for (int ai = 0; ai < 2; ++ai)
#pragma unroll
            for (int m = 0; m < 4; ++m) { const int row = rowb + ai * 128 + m * 16;
                const f32x4 a = *(const gf32x4*)(QSS + (size_t)row * 8), b = *(const gf32x4*)(QSS + (size_t)row * 8 + 4);
                const float r = rsqrtf((((a.x + a.y) + (a.z + a.w)) + ((b.x + b.y) + (b.z + b.w))) * (1.f / 384.f) + EPS) * scale;
#pragma unroll
                for (int bj = 0; bj < 2; ++bj) { float o[8];
#pragma unroll
                    for (int n = 0; n < 2; ++n)
#pragma unroll
                        for (int e = 0; e < 4; ++e) o[4 * n + e] = acc[ai][bj][m][n][e] * r;
                    if (u.pn == 2) rope8(o, ROPE + (size_t)(row & Lmask) * 32, fq);
                    *(gu32x4*)(QB + (size_t)row * 768 + colin + bj * 128) = pack8(o); } }
    }
};
struct EpiMlaKV {
    static constexpr bool PERM = true, MID = false;
    DI void operator()(AccC acc, const Unit& u, int wr, int wc, int fr, int fq) const {
        gu8* ws = kws(); gbf16* KVB = (gbf16*)(ws + WS_KVB); const gf32* KSS = (const gf32*)(ws + WS_KSS);
        const int rowb = u.pm * 256 + wr * 64 + fr, colin = u.pn * 256 + wc * 32 + 8 * fq;
#pragma unroll
        for (int ai = 0; ai < 2; ++ai)
#pragma unroll
            for (int m = 0; m < 4; ++m) { const int row = rowb + ai * 128 + m * 16;
                const f32x4 a = *(const gf32x4*)(KSS + (size_t)row * 4);
                const float r = rsqrtf(((a.x + a.y) + (a.z + a.w)) * (1.f / 128.f) + EPS);
#pragma unroll
                for (int bj = 0; bj < 2; ++bj) { float o[8];
#pragma unroll
                    for (int n = 0; n < 2; ++n)
#pragma unroll
                        for (int e = 0; e < 4; ++e) o[4 * n + e] = acc[ai][bj][m][n][e] * r;
                    *(gu32x4*)(KVB + (size_t)row * 1024 + colin + bj * 128) = pack8(o); } }
    }
};
struct EpiLru {
    static constexpr bool PERM = true, MID = false;
    int layer;
    DI void operator()(AccC acc, const Unit& u, int wr, int wc, int fr, int fq) const {
        gu8* ws = kws(); gf32* AU = (gf32*)(ws + WS_AU); const gbf16* XC = (const gbf16*)(ws + WS_XC);
        const gf32* b_a = kin(15) + layer * 1024; const gf32* b_x = kin(17) + layer * 1024; const gf32* lam = kin(18) + layer * 1024;
        const int rowb = u.pm * 256 + wr * 64 + fr, ch0 = u.pn * 64 + wc * 16 + 4 * fq;
#pragma unroll
        for (int bj = 0; bj < 2; ++bj) {
            const f32x4 ba = *(const gf32x4*)(b_a + bj * 512 + ch0), bx = *(const gf32x4*)(b_x + bj * 512 + ch0), lm = *(const gf32x4*)(lam + bj * 512 + ch0);
            float sp[4];
#pragma unroll
            for (int e = 0; e < 4; ++e) sp[e] = -8.f * log1pf(__expf(-lm[e]));
#pragma unroll
            for (int ai = 0; ai < 2; ++ai)
#pragma unroll
                for (int m = 0; m < 4; ++m) { const int row = rowb + ai * 128 + m * 16;
                    const u32x2 xw = *(const gu32x2*)(XC + (size_t)row * 512 + ch0);
                    const float xc[4] = {__uint_as_float(xw.x << 16), __uint_as_float(xw.x & 0xffff0000u), __uint_as_float(xw.y << 16), __uint_as_float(xw.y & 0xffff0000u)};
                    float o[8];
#pragma unroll
                    for (int e = 0; e < 4; ++e) { const float pr = acc[ai][bj][m][e >> 1][(e & 1) * 2], pi = acc[ai][bj][m][e >> 1][(e & 1) * 2 + 1];
                        const float r = sigmoidf_(pr + ba[e]), ig = sigmoidf_(pi + bx[e]);
                        const float la = r * sp[e]; const float a1 = __expf(la); o[2 * e] = a1; o[2 * e + 1] = sqrtf(fmaxf(1.f - a1 * a1, 0.f)) * (ig * xc[e]); }
                    gf32* dst = AU + ((size_t)(row * 2 + bj) * 512 + ch0) * 2;
                    *(gf32x4*)dst = (f32x4){o[0], o[1], o[2], o[3]}; *(gf32x4*)(dst + 4) = (f32x4){o[4], o[5], o[6], o[7]};
                    asm volatile("" ::: "memory"); }
        }
    }
};
struct EpiBranch {
    static constexpr bool PERM = true, MID = true;
    DI void mid(AccM acc, const Unit& u, int b, int wr, int wc, int fr, int fq) const {
        const gbf16* G = (const gbf16*)(kws() + WS_G);
        const int rowb = u.pm * 256 + wr * 64 + fr, col = u.pn * 256 + wc * 32 + 8 * fq;
#pragma unroll
        for (int ai = 0; ai < 2; ++ai)
#pragma unroll
            for (int m = 0; m < 4; ++m) { const gbf16* gp = G + (size_t)(rowb + ai * 128 + m * 16) * NGATE + col;
#pragma unroll
                for (int bj = 0; bj < 2; ++bj) { const u32x4 w0 = *(const gu32x4*)(gp + (b - 1) * 2048 + bj * 128), w1 = *(const gu32x4*)(gp + b * 2048 + bj * 128);
                    float g0[8], g1[8]; unpack8(w0, g0); unpack8(w1, g1);
#pragma unroll
                    for (int n = 0; n < 2; ++n)
#pragma unroll
                        for (int e = 0; e < 4; ++e) acc[ai][bj][m][n][e] *= fmaxf(g0[4 * n + e], 1e-18f) * __builtin_amdgcn_rcpf(fmaxf(g1[4 * n + e], 1e-18f)); } }
    }
    DI void operator()(AccC acc, const Unit& u, int wr, int wc, int fr, int fq) const {
        gu8* ws = kws(); const gbf16* G = (const gbf16*)(ws + WS_G); gbf16* MG = (gbf16*)(ws + WS_MG);
        const int rowb = u.pm * 256 + wr * 64 + fr, col = u.pn * 256 + wc * 32 + 8 * fq;
#pragma unroll
        for (int ai = 0; ai < 2; ++ai)
#pragma unroll
            for (int m = 0; m < 4; ++m) { const int row = rowb + ai * 128 + m * 16;
#pragma unroll
                for (int bj = 0; bj < 2; ++bj) { const u32x4 w3 = *(const gu32x4*)(G + (size_t)row * NGATE + 3 * 2048 + col + bj * 128); float g3[8]; unpack8(w3, g3); float o[8];
#pragma unroll
                    for (int n = 0; n < 2; ++n)
#pragma unroll
                        for (int e = 0; e < 4; ++e) o[4 * n + e] = acc[ai][bj][m][n][e] * fmaxf(g3[4 * n + e], 1e-18f);
                    *(gu32x4*)(MG + (size_t)row * DM + col + bj * 128) = pack8(o); } }
    }
};
}

namespace att {
typedef short v4i16_t __attribute__((ext_vector_type(4)));
constexpr int KSTR64 = 144, KSTR96 = 208, VSTR = 192;
DI int crow(int r, int h) { return (r & 3) + 8 * (r >> 2) + 4 * h; }
DI s16x4 vtr(const LAS unsigned char* p) { return __builtin_bit_cast(s16x4, __builtin_amdgcn_ds_read_tr16_b64_v4i16((LAS v4i16_t*)p)); }
DI unsigned cvtpk(float lo, float hi) { typedef __bf16 bf2 __attribute__((ext_vector_type(2))); f32x2 v = {lo, hi}; bf2 b = __builtin_convertvector(v, bf2); return __builtin_bit_cast(unsigned, b); }

struct NoMask { DI float operator()(float s, int) const { return s; } };
struct BandMask {
    int kq; float slope2; int R;
    DI float operator()(float s, int koff) const { const int rel = kq + koff; const int ar = rel < 0 ? -rel : rel; return ar <= R ? s - slope2 * (float)ar : -1e30f; }
};

template <int NKS, int KSTR, class Mask>
DI void tile(const LAS unsigned char* kt, const LAS unsigned char* vt, const bf16x8 (&qf)[NKS], f32x16 (&o)[2], float& m, float& l, int lane, const Mask& mk) {
    const int r32 = lane & 31, h = lane >> 5;
    f32x16 s;
#pragma unroll
    for (int r = 0; r < 16; ++r) s[r] = 0.f;
    const LAS unsigned char* kp = kt + r32 * KSTR + h * 16;
#pragma unroll
    for (int ks = 0; ks < NKS; ++ks) { const bf16x8 kf = *(const LAS bf16x8*)(kp + ks * 32); s = __builtin_amdgcn_mfma_f32_32x32x16_bf16(kf, qf[ks], s, 0, 0, 0); }
    float tmax = -1e30f;
#pragma unroll
    for (int r = 0; r < 16; ++r) { s[r] = mk(s[r], crow(r, h)); tmax = fmaxf(tmax, s[r]); }
    tmax = fmaxf(tmax, __shfl_xor(tmax, 32));
    const float mnew = fmaxf(m, tmax);
    if (__any(mnew > m)) { const float al = __builtin_amdgcn_exp2f(m - mnew); l *= al;
#pragma unroll
        for (int r = 0; r < 16; ++r) { o[0][r] *= al; o[1][r] *= al; } }
    m = mnew;
    float p[16]; float ps = 0.f;
#pragma unroll
    for (int r = 0; r < 16; ++r) { p[r] = s[r] > -1e29f ? __builtin_amdgcn_exp2f(s[r] - mnew) : 0.f; ps += p[r]; }
    l += ps;
    bf16x8 pf[2];
#pragma unroll
    for (int st = 0; st < 2; ++st) { u32x4 w; w.x = cvtpk(p[8 * st], p[8 * st + 1]); w.y = cvtpk(p[8 * st + 2], p[8 * st + 3]); w.z = cvtpk(p[8 * st + 4], p[8 * st + 5]); w.w = cvtpk(p[8 * st + 6], p[8 * st + 7]);
        pf[st] = __builtin_bit_cast(bf16x8, w); }
    const int i16 = lane & 15, q4 = i16 >> 2, p4 = i16 & 3, g1 = (lane >> 4) & 1;
    const LAS unsigned char* vp = vt + (4 * h + q4) * VSTR + g1 * 32 + p4 * 8;
#pragma unroll
    for (int db = 0; db < 2; ++db)
#pragma unroll
        for (int st = 0; st < 2; ++st) {
            const s16x4 lo = vtr(vp + (16 * st) * VSTR + db * 64), hi = vtr(vp + (16 * st + 8) * VSTR + db * 64);
            const bf16x8 vf = (bf16x8){lo[0], lo[1], lo[2], lo[3], hi[0], hi[1], hi[2], hi[3]};
            o[db] = __builtin_amdgcn_mfma_f32_32x32x16_bf16(vf, pf[st], o[db], 0, 0, 0);
        }
}
DI void store_o(const f32x16 (&o)[2], float inv, gbf16* Orow, int h) {
#pragma unroll
    for (int db = 0; db < 2; ++db)
#pragma unroll
        for (int g4 = 0; g4 < 4; ++g4) { u32x2 w; w.x = pk2(o[db][4 * g4] * inv, o[db][4 * g4 + 1] * inv); w.y = pk2(o[db][4 * g4 + 2] * inv, o[db][4 * g4 + 3] * inv);
            *(gu32x2*)(Orow + 32 * db + 8 * g4 + 4 * h) = w; }
}

template <int R, bool SINK>
DI void banded_unit(LAS unsigned char* lds, const gbf16* Kp, const gbf16* Vp, size_t rs, int w0, int w1, bool active, const gbf16* Qp, int qw, float slope2, float sink2,
                    gbf16* Op, size_t ors, gf32* Lp, size_t lrs) {
    constexpr int VOFF = 384 * KSTR64;
    const int tid = ltid(), lane = tid & 63, r32 = lane & 31, h = lane >> 5;
    const int nrow = w1 - w0;
    for (int idx = tid; idx < nrow * 8; idx += NTHREADS) { const int i = idx >> 3, c = idx & 7;
        const u32x4 kv = *(const gu32x4*)(Kp + (size_t)(w0 + i) * rs + c * 8); const u32x4 vv = *(const gu32x4*)(Vp + (size_t)(w0 + i) * rs + c * 8);
        *(LAS u32x4*)(lds + i * KSTR64 + c * 16) = kv; *(LAS u32x4*)(lds + VOFF + i * VSTR + c * 16) = vv; }
    __syncthreads();
    if (active) {
        bf16x8 qf[4];
        const gbf16* qrow = Qp + (size_t)(qw + r32) * rs;
#pragma unroll
        for (int ks = 0; ks < 4; ++ks) qf[ks] = *(const gbf16x8*)(qrow + 16 * ks + 8 * h);
        f32x16 o[2];
#pragma unroll
        for (int r = 0; r < 16; ++r) { o[0][r] = 0.f; o[1][r] = 0.f; }
        float m = -1e30f, l = 0.f;
        int k0 = qw - R; if (k0 < w0) k0 = w0; int k1 = qw + 32 + R; if (k1 > w1) k1 = w1;
        for (int kt = k0; kt < k1; kt += 32) {
            BandMask mk; mk.kq = kt - (qw + r32); mk.slope2 = slope2; mk.R = R;
            tile<4, KSTR64, BandMask>(lds + (kt - w0) * KSTR64, lds + VOFF + (kt - w0) * VSTR, qf, o, m, l, lane, mk);
        }
        l += __shfl_xor(l, 32);
        if (SINK) l += __builtin_amdgcn_exp2f(sink2 - m);
        const float inv = 1.f / l;
        store_o(o, inv, Op + (size_t)(qw + r32) * ors, h);
        if (Lp != nullptr && h == 0) Lp[(size_t)(qw + r32) * lrs] = (m + __builtin_amdgcn_logf(l)) * LN2;
    }
    __syncthreads();
}

DI void mla_unit(LAS unsigned char* lds, const gbf16* Kn, const gbf16* Kr, const gbf16* Vp, int L, const gbf16* Qn, const gbf16* Qr, gbf16* Op) {
    constexpr int BUF = 128 * KSTR96 + 128 * VSTR, VOFF = 128 * KSTR96;
    const int tid = ltid(), lane = tid & 63, r32 = lane & 31, h = lane >> 5, wid = tid >> 6;
    bf16x8 qf[6];
    { const gbf16* qn = Qn + (size_t)(wid * 32 + r32) * 768; const gbf16* qr = Qr + (size_t)(wid * 32 + r32) * 768;
#pragma unroll
      for (int ks = 0; ks < 4; ++ks) qf[ks] = *(const gbf16x8*)(qn + 16 * ks + 8 * h);
#pragma unroll
      for (int ks = 0; ks < 2; ++ks) qf[4 + ks] = *(const gbf16x8*)(qr + 16 * ks + 8 * h); }
    f32x16 o[2];
#pragma unroll
    for (int r = 0; r < 16; ++r) { o[0][r] = 0.f; o[1][r] = 0.f; }
    float m = -1e30f, l = 0.f;
    u32x4 pre[5];
    const int ns = L / 128;
#define MLA_LOAD(st) do { _Pragma("unroll") for (int j = 0; j < 5; ++j) { const int idx = tid + NTHREADS * j, row = idx / 20, c = idx % 20; const size_t key = (size_t)(st) * 128 + row; \
        const gbf16* src = c < 8 ? Kn + key * 1024 + c * 8 : (c < 12 ? Kr + key * NPROJ + (c - 8) * 8 : Vp + key * 1024 + (c - 12) * 8); pre[j] = *(const gu32x4*)src; } } while (0)
#define MLA_WRITE(b) do { _Pragma("unroll") for (int j = 0; j < 5; ++j) { const int idx = tid + NTHREADS * j, row = idx / 20, c = idx % 20; \
        LAS unsigned char* dst = lds + (b) * BUF + (c < 12 ? row * KSTR96 + c * 16 : VOFF + row * VSTR + (c - 12) * 16); *(LAS u32x4*)dst = pre[j]; } } while (0)
    MLA_LOAD(0); MLA_WRITE(0);
    __syncthreads();
    for (int st = 0; st < ns; ++st) {
        const int b = st & 1;
        if (st + 1 < ns) MLA_LOAD(st + 1);
#pragma unroll 1
        for (int j = 0; j < 4; ++j) tile<6, KSTR96, NoMask>(lds + b * BUF + j * 32 * KSTR96, lds + b * BUF + VOFF + j * 32 * VSTR, qf, o, m, l, lane, NoMask());
        if (st + 1 < ns) MLA_WRITE(b ^ 1);
        __syncthreads();
    }
#undef MLA_LOAD
#undef MLA_WRITE
    l += __shfl_xor(l, 32);
    store_o(o, 1.f / l, Op + (size_t)(wid * 32 + r32) * DM, h);
}
}

#define XB_TMO      128
#define XB_XCNT(j)  (256  + 64 * (j))
#define XB_XSUB(j)  (1280 + 64 * (j))
#define XB_XGEN(j)  (2304 + 64 * (j))
#define XB_TOP      3328
#define XB_TOPGEN   3392
#define XCD_BAR_WORDS 3456
#define XB_SPIN_CAP (1u << 20)

DI unsigned xb_ld(unsigned* p)              { return __hip_atomic_load(p, __ATOMIC_RELAXED, __HIP_MEMORY_SCOPE_AGENT); }
DI unsigned xb_add(unsigned* p, unsigned v) { return __hip_atomic_fetch_add(p, v, __ATOMIC_RELAXED, __HIP_MEMORY_SCOPE_AGENT); }
DI unsigned xb_xcc_id() { return (unsigned)__builtin_amdgcn_s_getreg((3 << 11) | 20) & 0xFu; }
#define XB_SPIN(cond, bar) do { unsigned _sp = 0; while (cond) { __builtin_amdgcn_s_sleep(1); \
    if ((++_sp & 255u) == 0u) { if (xb_ld(&(bar)[XB_TMO])) break; if (_sp > XB_SPIN_CAP) { atomicAdd(&(bar)[XB_TMO], 1u); break; } } } } while (0)

struct XcdBarrier { unsigned* bar; unsigned x; volatile LAS unsigned* st; };

DI XcdBarrier xcd_barrier_post(unsigned* bar, volatile LAS unsigned* st) {
    XcdBarrier b; b.bar = bar; b.x = xb_xcc_id(); b.st = st;
    if (threadIdx.x == 0) (void)xb_add(&bar[XB_XCNT(b.x)], 1u);
    return b;
}
DI void xcd_barrier_complete(unsigned* bar, unsigned x, unsigned& nloc, unsigned& nx) {
    const unsigned G = gridDim.x * gridDim.y * gridDim.z;
    unsigned sum, cnt, mine, sp = 0u;
    for (;;) {
        sum = 0u; cnt = 0u; mine = 0u;
#pragma unroll
        for (unsigned j = 0; j < 16; ++j) { const unsigned c = xb_ld(&bar[XB_XCNT(j)]); sum += c; cnt += (c > 0u) ? 1u : 0u; mine = (j == x) ? c : mine; }
        if (sum == G) break;
        __builtin_amdgcn_s_sleep(1);
        if ((++sp & 255u) == 0u) { if (xb_ld(&bar[XB_TMO])) break; if (sp > XB_SPIN_CAP) { atomicAdd(&bar[XB_TMO], 1u); break; } }
    }
    nloc = mine > 0u ? mine : 1u; nx = cnt > 0u ? cnt : 1u;
}
DI void xcd_barrier(const XcdBarrier& b) {
    asm volatile("s_waitcnt vmcnt(0)" ::: "memory");
    __syncthreads();
    if (threadIdx.x == 0) {
        unsigned* bar = b.bar;
        __builtin_amdgcn_s_waitcnt(0);
        unsigned nloc = b.st[0], nx = b.st[1];
        if (nloc == 0u) { xcd_barrier_complete(bar, b.x, nloc, nx); b.st[0] = nloc; b.st[1] = nx; }
        const unsigned old = xb_add(&bar[XB_XSUB(b.x)], 1u);
        const unsigned gen = old / nloc;
        if (old + 1u == (gen + 1u) * nloc) {
            __builtin_amdgcn_fence(__ATOMIC_RELEASE, "agent");
            asm volatile("s_waitcnt vmcnt(0)" ::: "memory");
            const unsigned og = xb_add(&bar[XB_TOP], 1u);
            const unsigned tg = og / nx;
            if (og + 1u == (tg + 1u) * nx) xb_add(&bar[XB_TOPGEN], 1u);
            else XB_SPIN(xb_ld(&bar[XB_TOPGEN]) == tg, bar);
            __builtin_amdgcn_fence(__ATOMIC_ACQUIRE, "agent");
            xb_add(&bar[XB_XGEN(b.x)], 1u);
            asm volatile("s_waitcnt vmcnt(0)" ::: "memory");
        } else {
            XB_SPIN(xb_ld(&bar[XB_XGEN(b.x)]) == gen, bar);
            __builtin_amdgcn_fence(__ATOMIC_ACQUIRE, "agent");
            asm volatile("s_waitcnt vmcnt(0)" ::: "memory");
        }
    }
    __syncthreads();
}

template <class Src>
DI void conv_item(const Src src, gbf16* WT, int K, int nblk, int item, LAS float* scr, int lane) {
    const int kb = item / nblk, nb = item % nblk, k0 = 64 * kb, n0 = 32 * nb;
#pragma unroll 8
    for (int i = 0; i < 32; ++i) { const int kk = 2 * i + (lane >> 5); scr[kk * 33 + (lane & 31)] = src(k0 + kk, n0 + (lane & 31)); }
    asm volatile("s_waitcnt lgkmcnt(0)" ::: "memory");
    const int c = lane & 7;
#pragma unroll
    for (int j = 0; j < 4; ++j) { const int n = (lane >> 3) + 8 * j; const LAS float* s = scr + (8 * c) * 33 + n;
        u32x4 o; o.x = pk2(s[0 * 33], s[1 * 33]); o.y = pk2(s[2 * 33], s[3 * 33]); o.z = pk2(s[4 * 33], s[5 * 33]); o.w = pk2(s[6 * 33], s[7 * 33]);
        *(gu32x4*)(WT + (size_t)(n0 + n) * K + k0 + 8 * c) = o; }
    asm volatile("s_waitcnt lgkmcnt(0)" ::: "memory");
}
struct SrcUp { const gf32* w1; const gf32* w3; const gf32* g;
    DI float operator()(int k, int n) const { const int j = (n >> 8) * 128 + (n & 127); const uintptr_t d = (uintptr_t)w3 - (uintptr_t)w1;
        const gf32* w = (const gf32*)((uintptr_t)w1 + ((n & 128) ? d : (uintptr_t)0)); return w[(size_t)k * DFF + j] * g[k]; } };
struct SrcPlain { const gf32* w; int N;
    DI float operator()(int k, int n) const { return w[(size_t)k * N + n]; } };
struct SrcIn { const gf32* w; const gf32* g;
    DI float operator()(int k, int n) const {
        int s;
        if (n < 5120) s = n;
        else if (n < 5152) { const int j = n - 5120; s = 5120 + (j >> 1) + 16 * (j & 1); }
        else if (n < 5376) s = -1;
        else if (n < 6144) s = 5152 + (n - 5376);
        else if (n < 7168) s = 5920 + (n - 6144);
        else s = 6944 + (n - 7168);
        return s < 0 ? 0.f : w[(size_t)k * N_IN + s] * g[k]; } };
struct SrcUq { const gf32* w; const gf32* g;
    DI float operator()(int k, int n) const { int s; if (n < 512) s = (n >> 6) * 96 + (n & 63); else { const int j = n - 512, hh = j >> 5, jj = j & 31; s = hh * 96 + 64 + (jj >> 1) + 16 * (jj & 1); }
        return w[(size_t)k * 768 + s] * g[k]; } };
struct SrcUkv { const gf32* w; const gf32* g;
    DI float operator()(int k, int n) const { if (k >= 128) return 0.f; const int s = (n < 512) ? (n >> 6) * 128 + (n & 63) : ((n - 512) >> 6) * 128 + 64 + (n & 63);
        return w[(size_t)k * 1024 + s] * g[k]; } };
struct SrcLru { const gf32* wa; const gf32* wx;
    DI float operator()(int k, int n) const { const int b = n >> 8, dir = (n >> 7) & 1, e = (n & 127) >> 1, jq = k >> 6, ei = k & 63; if (jq != (b & 3)) return 0.f;
        const uintptr_t d = (uintptr_t)wx - (uintptr_t)wa; const gf32* w = (const gf32*)((uintptr_t)wa + ((n & 1) ? d : (uintptr_t)0)); return w[((size_t)(dir * 8 + b) * 64 + ei) * 64 + e]; } };
struct SrcBr { const gf32* w;
    DI float operator()(int k, int n) const { return w[(size_t)k * DM + n]; } };

#ifndef PH_P0
#define PH_P0 1
#endif
#ifndef PH_WCONV
#define PH_WCONV 1
#endif
#ifndef PH_M1
#define PH_M1 1
#endif
#ifndef PH_M2A
#define PH_M2A 1
#endif
#ifndef PH_M2B
#define PH_M2B 1
#endif
#ifndef PH_M2C
#define PH_M2C 1
#endif
#ifndef PH_M3
#define PH_M3 1
#endif
#ifndef PH_MX
#define PH_MX 1
#endif
#ifndef PH_S1
#define PH_S1 1
#endif
#ifndef PH_MY
#define PH_MY 1
#endif
#ifndef PH_S2
#define PH_S2 1
#endif
#ifndef PH_MZ
#define PH_MZ 1
#endif
#ifndef PH_S3
#define PH_S3 1
#endif
#ifndef PH_MERGE
#define PH_MERGE 1
#endif
#ifndef PH_M7
#define PH_M7 1
#endif
#ifndef PH_M8
#define PH_M8 1
#endif
#ifndef PH_UP
#define PH_UP 1
#endif
#ifndef PH_DN
#define PH_DN 1
#endif
#ifndef PH_FIN
#define PH_FIN 1
#endif
#ifndef REP_P0
#define REP_P0 1
#endif
#ifndef REP_WCONV
#define REP_WCONV 1
#endif
#ifndef REP_M1
#define REP_M1 1
#endif
#ifndef REP_M2A
#define REP_M2A 1
#endif
#ifndef REP_M2B
#define REP_M2B 1
#endif
#ifndef REP_M2C
#define REP_M2C 1
#endif
#ifndef REP_M3
#define REP_M3 1
#endif
#ifndef REP_MX
#define REP_MX 1
#endif
#ifndef REP_S1
#define REP_S1 1
#endif
#ifndef REP_MY
#define REP_MY 1
#endif
#ifndef REP_S2
#define REP_S2 1
#endif
#ifndef REP_MZ
#define REP_MZ 1
#endif
#ifndef REP_S3
#define REP_S3 1
#endif
#ifndef REP_MERGE
#define REP_MERGE 1
#endif
#ifndef REP_M7
#define REP_M7 1
#endif
#ifndef REP_UP
#define REP_UP 1
#endif
#ifndef REP_M8
#define REP_M8 1
#endif
#ifndef REP_DN
#define REP_DN 1
#endif
struct Params { const float* in[27]; float* out; unsigned char* ws; };

#define GRID_BAR() do { XcdBarrier bar_; bar_.bar = (unsigned*)(kws() + WS_CTL) + CW_BAR; bar_.x = xb_xcc_id(); bar_.st = (volatile LAS unsigned*)(lds + MISC_OFF) + 8; xcd_barrier(bar_); } while (0)

__global__ void __launch_bounds__(NTHREADS, 2) trunk_fwd(Params P) {
    extern __shared__ __attribute__((aligned(16))) unsigned char lds_raw[];
    LAS unsigned char* lds = (LAS unsigned char*)lds_raw;
    (void)P;
    {
        const int tid = ltid();
        for (int u = tid; u < (LDS_BYTES - LDSCTL_OFF) / 4; u += NTHREADS) ((LAS unsigned*)(lds + LDSCTL_OFF))[u] = 0u;
        __syncthreads();
        (void)xcd_barrier_post((unsigned*)(kws() + WS_CTL) + CW_BAR, (volatile LAS unsigned*)(lds + MISC_OFF) + 8);
    }

#if PH_P0
    _Pragma("unroll 1") for (int rep_ = 0; rep_ < REP_P0; ++rep_) {
        const int tid = ltid(), lane = tid & 63, wave = tid >> 6, G = lgrid(), bid = lbid();
        gu8* ws = kws(); gf32* X = kout(); gbf16* XB = (gbf16*)(ws + WS_XB); gf32* SS = (gf32*)(ws + WS_SS); gf32* ROPE = (gf32*)(ws + WS_ROPE);
        const gf32* xp = kin(0); const gf32* xs = kin(1);
        for (int i = bid * NTHREADS + tid; i < 4096 * 16; i += G * NTHREADS) { const int pos = i >> 4, j = i & 15;
            const float inv = __builtin_amdgcn_exp2f(-(float)j * (13.287712379549449f / 16.f));
            const float ang = (float)pos * inv;
            double rev = (double)ang * 0.15915494309189535; rev -= (double)(long long)rev;
            ROPE[2 * i] = __builtin_amdgcn_cosf((float)rev); ROPE[2 * i + 1] = __builtin_amdgcn_sinf((float)rev); }
        for (int r = bid * NWAVES + wave; r < MTOT; r += G * NWAVES) {
            const gf32* src = (r < M_PROMPT) ? xp + (size_t)r * DM : xs + (size_t)(r - M_PROMPT) * DM;
            const gf32x4* xr = (const gf32x4*)src + lane; f32x4 v[8]; float s = 0.f;
#pragma unroll
            for (int j = 0; j < 8; ++j) { v[j] = xr[64 * j]; s += (v[j].x * v[j].x + v[j].y * v[j].y) + (v[j].z * v[j].z + v[j].w * v[j].w); }
            s = wave_sum(s);
            gf32x4* xo = (gf32x4*)(X + (size_t)r * DM) + lane; gu32x2* bo = (gu32x2*)(XB + (size_t)r * DM) + lane;
#pragma unroll
            for (int j = 0; j < 8; ++j) { xo[64 * j] = v[j]; u32x2 w; w.x = pk2(v[j].x, v[j].y); w.y = pk2(v[j].z, v[j].w); bo[64 * j] = w; }
            if (lane < 32) SS[(size_t)r * 32 + lane] = (lane == 0) ? s : 0.f;
        }
    }
#endif

#pragma unroll 1
    for (int layer = 0; layer < DEPTH; ++layer) {
#if PH_WCONV
        _Pragma("unroll 1") for (int rep_ = 0; rep_ < REP_WCONV; ++rep_) {
            const int tid = ltid(), lane = tid & 63, wave = tid >> 6, G = lgrid(), bid = lbid();
            LAS float* scr = (LAS float*)(lds + wave * 16384);
            gu8* ws = kws();
            const size_t wsz = (size_t)DM * DFF;
            constexpr int I_UP = (DM / 64) * (11264 / 32), I_DN = (DFF / 64) * (DM / 32), I_IN = (DM / 64) * (NIN_PAD / 32), I_SQ = (DM / 64) * (DM / 32);
            constexpr int I_UQ = (384 / 64) * (768 / 32), I_UKV = (256 / 64) * (1024 / 32), I_LRU = (256 / 64) * (2048 / 32);
            constexpr int NITEMS = 2 * I_UP + 2 * I_DN + I_IN + 2 * I_SQ + I_UQ + I_UKV + I_LRU;
#pragma unroll 1
            for (int it = bid * NWAVES + wave; it < NITEMS; it += G * NWAVES) {
                int r = it;
                if (r < I_UP) { const SrcUp s{kin(3) + layer * wsz, kin(4) + layer * wsz, kin(2) + layer * DM}; conv_item(s, (gbf16*)(ws + WS_WUP), DM, 11264 / 32, r, scr, lane); continue; } r -= I_UP;
                if (r < I_UP) { const SrcUp s{kin(23) + layer * wsz, kin(24) + layer * wsz, kin(22) + layer * DM}; conv_item(s, (gbf16*)(ws + WS_WUP) + (size_t)11264 * DM, DM, 11264 / 32, r, scr, lane); continue; } r -= I_UP;
                if (r < I_DN) { const SrcPlain s{kin(5) + layer * wsz, DM}; conv_item(s, (gbf16*)(ws + WS_WDN), DFF, DM / 32, r, scr, lane); continue; } r -= I_DN;
                if (r < I_DN) { const SrcPlain s{kin(25) + layer * wsz, DM}; conv_item(s, (gbf16*)(ws + WS_WDN) + (size_t)DM * DFF, DFF, DM / 32, r, scr, lane); continue; } r -= I_DN;
                if (r < I_IN) { const SrcIn s{kin(7) + (size_t)layer * DM * N_IN, kin(6) + layer * DM}; conv_item(s, (gbf16*)(ws + WS_WIN), DM, NIN_PAD / 32, r, scr, lane); continue; } r -= I_IN;
                if (r < I_SQ) { const SrcBr s{kin(20) + (size_t)layer * 4 * 512 * DM}; conv_item(s, (gbf16*)(ws + WS_WBR), DM, DM / 32, r, scr, lane); continue; } r -= I_SQ;
                if (r < I_SQ) { const SrcPlain s{kin(21) + (size_t)layer * DM * DM, DM}; conv_item(s, (gbf16*)(ws + WS_WOUT), DM, DM / 32, r, scr, lane); continue; } r -= I_SQ;
                if (r < I_UQ) { const SrcUq s{kin(9) + (size_t)layer * 384 * 768, kin(8) + layer * 384}; conv_item(s, (gbf16*)(ws + WS_WUQ), 384, 768 / 32, r, scr, lane); continue; } r -= I_UQ;
                if (r < I_UKV) { const SrcUkv s{kin(11) + (size_t)layer * 128 * 1024, kin(10) + layer * 128}; conv_item(s, (gbf16*)(ws + WS_WUKV), 256, 1024 / 32, r, scr, lane); continue; } r -= I_UKV;
                { const SrcLru s{kin(14) + (size_t)layer * 2 * 8 * 64 * 64, kin(16) + (size_t)layer * 2 * 8 * 64 * 64}; conv_item(s, (gbf16*)(ws + WS_WLRU), 256, 2048 / 32, r, scr, lane); }
            }
        }
#endif
        GRID_BAR();

#pragma unroll 1
        for (int f = 0; f < 2; ++f) {
            if (f == 1) {
#pragma unroll 1
                for (int ch = 0; ch < NCHUNK; ++ch) {
                    const int row0 = ch * MC; const int L = (row0 < M_PROMPT) ? 2048 : 4096; const int nseq = MC / L;
#if PH_M1
                    _Pragma("unroll 1") for (int rep_ = 0; rep_ < REP_M1; ++rep_) {
                        gu8* ws = kws();
                        pg8::Gemm g{(const gbf16*)(ws + WS_XB) + (size_t)row0 * DM, (const gbf16*)(ws + WS_WIN), MC, 1024, DM, DM, DM, 0, 0}; pg8::StaticOrder S; S.init(MC, 1024, lgrid(), lbid(), 24);
                        epi::EpiProj E{row0, L - 1};
                        pg8::gemm_phase<epi::EpiProj, true>(lds, g, S, E);
                    }
#endif
                    GRID_BAR();
#if PH_M2A
                    _Pragma("unroll 1") for (int rep_ = 0; rep_ < REP_M2A; ++rep_) {
                        const int tid = ltid(), G = lgrid(), bid = lbid();
                        gu8* ws = kws(); const gbf16* PROJ = (const gbf16*)(ws + WS_PROJ); gbf16* XC = (gbf16*)(ws + WS_XC);
                        const gf32* cw = kin(12) + layer * 4 * 512; const gf32* cb = kin(13) + layer * 512;
                        for (int idx = bid * NTHREADS + tid; idx < MC * 64; idx += G * NTHREADS) { const int row = idx >> 6, c8 = (idx & 63) * 8, pos = row & (L - 1);
                            float a[8];
                            { const f32x4 b0 = *(const gf32x4*)(cb + c8), b1 = *(const gf32x4*)(cb + c8 + 4); a[0] = b0.x; a[1] = b0.y; a[2] = b0.z; a[3] = b0.w; a[4] = b1.x; a[5] = b1.y; a[6] = b1.z; a[7] = b1.w; }
#pragma unroll
                            for (int tap = 0; tap < 4; ++tap) { const int p2 = pos + tap - 2; if (p2 >= 0 && p2 < L) {
                                const u32x4 xw = *(const gu32x4*)(PROJ + (size_t)(row + tap - 2) * NPROJ + PC_XR + c8); float xv[8]; unpack8(xw, xv);
                                const f32x4 w0 = *(const gf32x4*)(cw + tap * 512 + c8), w1 = *(const gf32x4*)(cw + tap * 512 + c8 + 4);
                                a[0] += xv[0] * w0.x; a[1] += xv[1] * w0.y; a[2] += xv[2] * w0.z; a[3] += xv[3] * w0.w; a[4] += xv[4] * w1.x; a[5] += xv[5] * w1.y; a[6] += xv[6] * w1.z; a[7] += xv[7] * w1.w; } }
                            *(gu32x4*)(XC + (size_t)row * 512 + c8) = pack8(a); }
                    }
#endif
#if PH_M1
                    _Pragma("unroll 1") for (int rep_ = 0; rep_ < REP_M1; ++rep_) {
                        gu8* ws = kws();
                        pg8::Gemm g{(const gbf16*)(ws + WS_XB) + (size_t)row0 * DM, (const gbf16*)(ws + WS_WIN), MC, NIN_PAD - 1024, DM, DM, DM, 0, 0}; pg8::StaticOrder S; S.init(MC, NIN_PAD - 1024, lgrid(), lbid(), 0, 24, 4);
                        epi::EpiProj E{row0, L - 1};
                        pg8::gemm_phase<epi::EpiProj, true>(lds, g, S, E);
                    }
#endif
                    GRID_BAR();
#if PH_M3
                    _Pragma("unroll 1") for (int rep_ = 0; rep_ < REP_M3; ++rep_) {
                        gu8* ws = kws();
                        pg8::Gemm g{(const gbf16*)(ws + WS_XC), (const gbf16*)(ws + WS_WLRU), MC, 2048, 256, 512, 256, 2, 256}; pg8::StaticOrder S; S.init(MC, 2048, lgrid(), lbid());
                        epi::EpiLru E{layer};
                        pg8::gemm_phase<epi::EpiLru, true>(lds, g, S, E);
                    }
#endif
#if PH_M2B
                    _Pragma("unroll 1") for (int rep_ = 0; rep_ < REP_M2B; ++rep_) {
                        gu8* ws = kws();
                        pg8::Gemm g{(const gbf16*)(ws + WS_PROJ) + PC_CQ, (const gbf16*)(ws + WS_WUQ), MC, 768, 384, NPROJ, 384, 0, 0}; pg8::StaticOrder S; S.init(MC, 768, lgrid(), lbid());
                        epi::EpiMlaQ E{L - 1};
                        pg8::gemm_phase<epi::EpiMlaQ, true>(lds, g, S, E);
                    }
#endif
#if PH_M2C
                    _Pragma("unroll 1") for (int rep_ = 0; rep_ < REP_M2C; ++rep_) {
                        gu8* ws = kws();
                        pg8::Gemm g{(const gbf16*)(ws + WS_PROJ) + PC_CKV, (const gbf16*)(ws + WS_WUKV), MC, 1024, 256, NPROJ, 256, 0, 0}; pg8::StaticOrder S; S.init(MC, 1024, lgrid(), (lbid() + 192) % lgrid());
                        epi::EpiMlaKV E{};
                        pg8::gemm_phase<epi::EpiMlaKV, true>(lds, g, S, E);
                    }
#endif
#if PH_MY
                    _Pragma("unroll 1") for (int rep_ = 0; rep_ < REP_MY; ++rep_) {
                        const int tid = ltid(), wave = __builtin_amdgcn_readfirstlane(tid >> 6), G = lgrid(), bid = lbid();
                        gu8* ws = kws(); const gbf16* PROJ = (const gbf16*)(ws + WS_PROJ); gbf16* OA = (gbf16*)(ws + WS_OA); gf32* LSE = (gf32*)(ws + WS_LSE);
                        int ubase = 0;
#pragma unroll 1
                        for (int gi = 0; gi < 3; ++gi) {
                            const int dil = (gi == 0) ? 1 : (gi == 1 ? 4 : 16); const int Lv = L / dil; const int QBR = Lv < 256 ? Lv : 256; const int nqb = Lv / QBR, nvs = nseq * dil;
                            const int nun = 8 * nvs * nqb;
                            int first = (bid - ubase) % G; if (first < 0) first += G;
#pragma unroll 1
                            for (int ui = first; ui < nun; ui += G) { const int qb = ui % nqb, vs = (ui / nqb) % nvs, hd = ui / (nqb * nvs); const int sq = vs / dil, res = vs % dil;
                                const size_t base = (size_t)sq * L + res;
                                const int q0 = qb * QBR; int w0 = q0 - 64; if (w0 < 0) w0 = 0; int w1 = q0 + QBR + 64; if (w1 > Lv) w1 = Lv;
                                const int qw = q0 + wave * 32; const bool active = wave * 32 < QBR;
                                att::banded_unit<64, false>(lds, PROJ + base * NPROJ + PC_AK + gi * 512 + hd * 64, PROJ + base * NPROJ + PC_AV + gi * 512 + hd * 64, (size_t)dil * NPROJ, w0, w1, active,
                                                            PROJ + base * NPROJ + PC_AQ + gi * 512 + hd * 64, qw, exp2f(-(float)(hd + 1)) * (float)dil * LOG2E, 0.f,
                                                            OA + ((size_t)gi * MC + base) * 512 + hd * 64, (size_t)dil * 512, LSE + ((size_t)gi * MC + base) * 8 + hd, (size_t)dil * 8); }
                            ubase += nun;
                        }
                    }
#endif
                    GRID_BAR();
#if PH_MX
                    _Pragma("unroll 1") for (int rep_ = 0; rep_ < REP_MX; ++rep_) {
                        const int G = lgrid(), bid = lbid();
                        gu8* ws = kws(); const gbf16* PROJ = (const gbf16*)(ws + WS_PROJ); const gbf16* KVB = (const gbf16*)(ws + WS_KVB); const gbf16* QB = (const gbf16*)(ws + WS_QB); gbf16* Y = (gbf16*)(ws + WS_Y);
                        const int nqb = L / 256, nunits = nseq * 8 * nqb;
#pragma unroll 1
                        for (int ui = bid; ui < nunits; ui += G) { const int qb = ui % nqb, hd = (ui / nqb) & 7, sq = ui / (nqb * 8);
                            const size_t srow = (size_t)sq * L, qrow = srow + (size_t)qb * 256;
                            att::mla_unit(lds, KVB + srow * 1024 + hd * 64, PROJ + srow * NPROJ + PC_KR, KVB + srow * 1024 + 512 + hd * 64, L,
                                          QB + qrow * 768 + hd * 64, QB + qrow * 768 + 512 + hd * 32, Y + qrow * DM + 512 + hd * 64);
                            __syncthreads(); }
                    }
#endif
#if PH_MZ
                    _Pragma("unroll 1") for (int rep_ = 0; rep_ < REP_MZ; ++rep_) {
                        const int tid = ltid(), wave = __builtin_amdgcn_readfirstlane(tid >> 6), G = lgrid(), bid = lbid();
                        gu8* ws = kws(); const gbf16* PROJ = (const gbf16*)(ws + WS_PROJ); gbf16* Y = (gbf16*)(ws + WS_Y);
                        const int nqb = L / 64, nunits = nseq * 2 * nqb;
                        const gf32* sink = kin(19) + layer * 8;
#pragma unroll 1
                        for (int ui = bid; ui < nunits; ui += G) { const int qb = ui % nqb, kvh = (ui / nqb) & 1, sq = ui / (nqb * 2);
                            const size_t base = (size_t)sq * L; const int q0 = qb * 64; int w0 = q0 - 128; if (w0 < 0) w0 = 0; int w1 = q0 + 64 + 128; if (w1 > L) w1 = L;
                            const int qh = kvh * 4 + (wave >> 1), qw = q0 + (wave & 1) * 32;
                            att::banded_unit<128, true>(lds, PROJ + base * NPROJ + PC_C + 512 + kvh * 64, PROJ + base * NPROJ + PC_C + 640 + kvh * 64, (size_t)NPROJ, w0, w1, true,
                                                        PROJ + base * NPROJ + PC_C + qh * 64, qw, exp2f(-(float)(qh + 1)) * LOG2E, sink[qh] * LOG2E,
                                                        Y + base * DM + 1024 + qh * 64, (size_t)DM, nullptr, 0); }
                    }
#endif
#if PH_S1
                    _Pragma("unroll 1") for (int rep_ = 0; rep_ < REP_S1; ++rep_) {
                        const int tid = ltid(), G = lgrid(), bid = lbid();
                        gu8* ws = kws(); const gf32x2* AU2 = (const gf32x2*)(ws + WS_AU); gf32x2* SUMF = (gf32x2*)(ws + WS_SUMF); gf32x2* SUMB = (gf32x2*)(ws + WS_SUMB);
                        for (int idx = bid * NTHREADS + tid; idx < (MC / 32) * 512; idx += G * NTHREADS) { const int c = idx & 511, blk = idx >> 9;
                            const gf32x2* au = AU2 + (size_t)blk * 32 * 1024 + c;
                            float Pf = 1.f, Hf = 0.f, Pb = 1.f, Hb = 0.f;
#pragma unroll 8
                            for (int t = 0; t < 32; ++t) { const f32x2 v = au[(size_t)t * 1024]; Hf = v.x * Hf + v.y; Pf *= v.x; }
#pragma unroll 8
                            for (int t = 31; t >= 0; --t) { const f32x2 v = au[(size_t)t * 1024 + 512]; Hb = v.x * Hb + v.y; Pb *= v.x; }
                            SUMF[idx] = (f32x2){Pf, Hf}; SUMB[idx] = (f32x2){Pb, Hb}; }
                    }
#endif
#if PH_MERGE
                    _Pragma("unroll 1") for (int rep_ = 0; rep_ < REP_MERGE; ++rep_) {
                        const int tid = ltid(), G = lgrid(), bid = lbid();
                        gu8* ws = kws(); gbf16* Y = (gbf16*)(ws + WS_Y); const gbf16* OA = (const gbf16*)(ws + WS_OA); const gf32* LSE = (const gf32*)(ws + WS_LSE);
                        for (int idx = bid * NTHREADS + tid; idx < MC * 64; idx += G * NTHREADS) { const int row = idx >> 6, hd = (idx >> 3) & 7, c8 = (idx & 63) * 8;
                            const float l0 = LSE[(size_t)row * 8 + hd], l1 = LSE[((size_t)MC + row) * 8 + hd], l2 = LSE[((size_t)2 * MC + row) * 8 + hd];
                            const float mx = fmaxf(l0, fmaxf(l1, l2)); float e0 = __expf(l0 - mx), e1 = __expf(l1 - mx), e2 = __expf(l2 - mx); const float inv = 1.f / (e0 + e1 + e2); e0 *= inv; e1 *= inv; e2 *= inv;
                            float a0[8], a1[8], a2[8]; unpack8(*(const gu32x4*)(OA + (size_t)row * 512 + c8), a0); unpack8(*(const gu32x4*)(OA + ((size_t)MC + row) * 512 + c8), a1); unpack8(*(const gu32x4*)(OA + ((size_t)2 * MC + row) * 512 + c8), a2);
                            float o[8];
#pragma unroll
                            for (int e = 0; e < 8; ++e) o[e] = e0 * a0[e] + e1 * a1[e] + e2 * a2[e];
                            *(gu32x4*)(Y + (size_t)row * DM + c8) = pack8(o); }
                    }
#endif
                    GRID_BAR();
#if PH_S3
                    _Pragma("unroll 1") for (int rep_ = 0; rep_ < REP_S3; ++rep_) {
                        const int tid = ltid(), G = lgrid(), bid = lbid();
                        gu8* ws = kws(); const gbf16* PROJ = (const gbf16*)(ws + WS_PROJ); gbf16* Y = (gbf16*)(ws + WS_Y);
                        const gf32x2* AU2 = (const gf32x2*)(ws + WS_AU); const gf32x2* SUMF = (const gf32x2*)(ws + WS_SUMF); const gf32x2* SUMB = (const gf32x2*)(ws + WS_SUMB);
                        const int NC = L / 32;
                        for (int idx = bid * NTHREADS + tid; idx < (MC / 32) * 512; idx += G * NTHREADS) { const int c = idx & 511, blk = idx >> 9, tc = blk & (NC - 1), sblk = blk - tc;
                            float hcur = 0.f;
#pragma unroll 4
                            for (int k = 0; k < tc; ++k) { const f32x2 e = SUMF[(size_t)(sblk + k) * 512 + c]; hcur = e.x * hcur + e.y; }
                            const gf32x2* au = AU2 + (size_t)blk * 32 * 1024 + c;
                            float hf[32];
#pragma unroll
                            for (int t = 0; t < 32; ++t) { const f32x2 v = au[(size_t)t * 1024]; hcur = v.x * hcur + v.y; hf[t] = hcur; }
                            hcur = 0.f;
#pragma unroll 4
                            for (int k = NC - 1; k > tc; --k) { const f32x2 e = SUMB[(size_t)(sblk + k) * 512 + c]; hcur = e.x * hcur + e.y; }
#pragma unroll
                            for (int t = 31; t >= 0; --t) { const f32x2 v = au[(size_t)t * 1024 + 512]; hcur = v.x * hcur + v.y;
                                const size_t row = (size_t)blk * 32 + t; const float gx = bf2f(PROJ[row * NPROJ + PC_GT + c]);
                                const float ge = 0.5f * gx * (1.f + tanhf(0.7978845608028654f * (gx + 0.044715f * gx * gx * gx)));
                                Y[row * DM + 1536 + c] = (bf16_t)f2bf((hf[t] + hcur) * ge); } }
                    }
#endif
                    GRID_BAR();
#if PH_M7
                    _Pragma("unroll 1") for (int rep_ = 0; rep_ < REP_M7; ++rep_) {
                        gu8* ws = kws();
                        pg8::Gemm g{(const gbf16*)(ws + WS_Y), (const gbf16*)(ws + WS_WBR), MC, DM, DM, DM, DM, 0, 0}; pg8::StaticOrder S; S.init(MC, DM, lgrid(), lbid());
                        epi::EpiBranch E{};
                        pg8::gemm_phase<epi::EpiBranch, true>(lds, g, S, E);
                    }
#endif
                    GRID_BAR();
#if PH_M8
                    _Pragma("unroll 1") for (int rep_ = 0; rep_ < REP_M8; ++rep_) {
                        gu8* ws = kws();
                        pg8::Gemm g{(const gbf16*)(ws + WS_MG), (const gbf16*)(ws + WS_WOUT), MC, DM, DM, DM, DM, 0, 0}; pg8::StaticOrder S; S.init(MC, DM, lgrid(), lbid());
                        epi::EpiResidual E{row0, rep_ == REP_M8 - 1 ? 1.0f : 0.0f};
                        pg8::gemm_phase<epi::EpiResidual, true>(lds, g, S, E);
                    }
#endif
                    GRID_BAR();
                }
            }
#if PH_UP
            _Pragma("unroll 1") for (int rep_ = 0; rep_ < REP_UP; ++rep_) {
                gu8* ws = kws();
                pg8::Gemm g{(const gbf16*)(ws + WS_XB), (const gbf16*)(ws + WS_WUP) + (size_t)f * 11264 * DM, MTOT, 11264, DM, DM, DM, 0, 0}; pg8::StaticOrder S; S.init(MTOT, 11264, lgrid(), lbid());
                epi::EpiSwiGLU E{};
                pg8::gemm_phase<epi::EpiSwiGLU, true>(lds, g, S, E);
            }
#endif
            GRID_BAR();
#if PH_DN
            _Pragma("unroll 1") for (int rep_ = 0; rep_ < REP_DN; ++rep_) {
                gu8* ws = kws();
                pg8::Gemm g{(const gbf16*)(ws + WS_BIG), (const gbf16*)(ws + WS_WDN) + (size_t)f * DM * DFF, MTOT, DM, DFF, DFF, DFF, 0, 0}; pg8::StaticOrder S; S.init(MTOT, DM, lgrid(), lbid());
                epi::EpiResidual E{0, rep_ == REP_DN - 1 ? 0.5f : 0.0f};
                pg8::gemm_phase<epi::EpiResidual, true>(lds, g, S, E);
            }
#endif
            GRID_BAR();
        }
    }
#if PH_FIN
    {
        const int tid = ltid(), lane = tid & 63, wave = tid >> 6, G = lgrid(), bid = lbid();
        gu8* ws = kws(); gf32* X = kout(); const gf32* SS = (const gf32*)(ws + WS_SS);
        const gf32* gn = kin(26);
        const unsigned tmo = __hip_atomic_load((unsigned*)(ws + WS_CTL) + CW_BAR + XB_TMO, __ATOMIC_RELAXED, __HIP_MEMORY_SCOPE_AGENT);
        for (int r = bid * NWAVES + wave; r < MTOT; r += G * NWAVES) {
            float s = (lane < 32) ? SS[(size_t)r * 32 + lane] : 0.f; s = wave_sum(s);
            float rstd = rsqrtf(s * (1.f / (float)DM) + EPS); if (tmo != 0u) rstd = __builtin_nanf("");
            gf32x4* xo = (gf32x4*)(X + (size_t)r * DM) + lane; const gf32x4* gp = (const gf32x4*)gn + lane;
#pragma unroll
            for (int j = 0; j < 8; ++j) { const f32x4 v = xo[64 * j], gg = gp[64 * j]; xo[64 * j] = v * rstd * gg; }
        }
    }
#endif
}

extern "C" void kernel_launch(void* const* d_in, const int* in_sizes, int n_in, void* d_out, int out_size, void* d_ws, size_t ws_size, hipStream_t stream) {
    static int grid = 0;
    if (grid == 0) {
        if (n_in != 27 || out_size != MTOT * DM || ws_size < WS_END) { fprintf(stderr, "kernel_launch: unexpected problem (n_in %d, out %d, ws %zu, need %zu); nothing launched\n", n_in, out_size, ws_size, (size_t)WS_END); grid = -1; return; }
        int dev = 0, cus = 0, per_cu = 0;
        if (hipGetDevice(&dev) != hipSuccess || hipDeviceGetAttribute(&cus, hipDeviceAttributeMultiprocessorCount, dev) != hipSuccess) { grid = -1; return; }
        if (hipFuncSetAttribute((const void*)trunk_fwd, hipFuncAttributeMaxDynamicSharedMemorySize, LDS_BYTES) != hipSuccess) { fprintf(stderr, "kernel_launch: hipFuncSetAttribute failed\n"); grid = -1; return; }
        if (hipOccupancyMaxActiveBlocksPerMultiprocessor(&per_cu, (const void*)trunk_fwd, NTHREADS, LDS_BYTES) != hipSuccess || per_cu < 1) { fprintf(stderr, "kernel_launch: occupancy query reports %d\n", per_cu); }
        (void)hipGetLastError();
        grid = cus;
    }
    if (grid < 0) return;
    (void)in_sizes;
    if (hipMemsetAsync((char*)d_ws + WS_CTL, 0, CTL_ZERO_BYTES, stream) != hipSuccess) return;
    Params p{};
    for (int i = 0; i < 27; ++i) p.in[i] = (const float*)d_in[i];
    p.out = (float*)d_out; p.ws = (unsigned char*)d_ws;
    hipLaunchKernelGGL(trunk_fwd, dim3(grid), dim3(NTHREADS), LDS_BYTES, stream, p);
}
```

```cpp
#include <hip/hip_runtime.h>
#include <cstdio>
#include <cstdint>

#define DI __device__ __forceinline__
#define LAS __attribute__((address_space(3)))
#define GAS __attribute__((address_space(1)))

typedef unsigned short bf16_t;
typedef short bf16x8 __attribute__((ext_vector_type(8)));
typedef short s16x4 __attribute__((ext_vector_type(4)));
typedef float f32x4 __attribute__((ext_vector_type(4)));
typedef float f32x2 __attribute__((ext_vector_type(2)));
typedef float f32x16 __attribute__((ext_vector_type(16)));
typedef unsigned u32x4 __attribute__((ext_vector_type(4)));
typedef unsigned u32x2 __attribute__((ext_vector_type(2)));

typedef GAS float gf32; typedef GAS bf16_t gbf16; typedef GAS unsigned char gu8; typedef GAS f32x4 gf32x4; typedef GAS f32x2 gf32x2; typedef GAS u32x4 gu32x4; typedef GAS u32x2 gu32x2; typedef GAS bf16x8 gbf16x8;

constexpr int DM = 2048, DFF = 5632, DEPTH = 2;
constexpr int M_PROMPT = 8 * 2048, M_SAMPLE = 8 * 4096, MTOT = M_PROMPT + M_SAMPLE;
constexpr int NCHUNK = 2;
constexpr int MCMAX = 32768;
constexpr int N_IN = 15136;
constexpr int NPROJ = 7168, NGATE = 8192, NIN_PAD = NPROJ + NGATE;
constexpr int PC_AQ = 0, PC_AK = 1536, PC_AV = 3072, PC_CQ = 4608, PC_CKV = 4992, PC_KR = 5120, PC_C = 5376, PC_XR = 6144, PC_GT = 6656;
constexpr float EPS = 1e-6f;
constexpr float LOG2E = 1.4426950408889634f, LN2 = 0.6931471805599453f;

constexpr size_t MiB = 1u << 20;
constexpr size_t WS_CTL = 0, CTL_ZERO_BYTES = 1 * MiB;
constexpr size_t WS_ROPE = 1 * MiB;
constexpr size_t WS_SS = 2 * MiB;
constexpr size_t WS_WUP = 8 * MiB;
constexpr size_t WS_WDN = WS_WUP + 88 * MiB;
constexpr size_t WS_WIN = WS_WDN + 44 * MiB;
constexpr size_t WS_WBR = WS_WIN + 60 * MiB;
constexpr size_t WS_WOUT = WS_WBR + 8 * MiB;
constexpr size_t WS_WUQ = WS_WOUT + 8 * MiB;
constexpr size_t WS_WUKV = WS_WUQ + 1 * MiB;
constexpr size_t WS_WLRU = WS_WUKV + 1 * MiB;
constexpr size_t WS_XB = 220 * MiB;
constexpr size_t WS_BIG = 412 * MiB;
constexpr size_t WS_PROJ = WS_BIG;
constexpr size_t WS_MG = WS_PROJ;
constexpr size_t WS_G = WS_PROJ + 448 * MiB;
constexpr size_t WS_KVB = WS_G + 256 * MiB;
constexpr size_t WS_QR = WS_KVB + 64 * MiB;
constexpr size_t WS_LSE = WS_QR + 16 * MiB;
constexpr size_t WS_QSS = WS_LSE + 3 * MiB;
constexpr size_t WS_KSS = WS_QSS + 1 * MiB;
constexpr size_t WS_SUMF = WS_KSS + 1 * MiB;
constexpr size_t WS_SUMB = WS_SUMF + 4 * MiB;
constexpr size_t WS_CSF = WS_SUMB + 4 * MiB;
constexpr size_t WS_CSB = WS_CSF + 1 * MiB;
constexpr size_t WS_MIX_END = WS_CSB + 1 * MiB;
constexpr size_t WS_END = WS_MIX_END;
static_assert(WS_WLRU + 1 * MiB <= WS_XB && WS_XB + 192 * MiB <= WS_BIG && WS_BIG + 528 * MiB <= WS_MIX_END && WS_END <= 1216 * MiB, "d_ws map");
constexpr size_t OUT_Y = 0;
constexpr size_t OUT_XC = OUT_Y;
constexpr size_t OUT_AU = OUT_Y + 128 * MiB;
constexpr size_t OUT_OA = OUT_AU + 128 * MiB;
constexpr size_t OUT_QN = OUT_OA + 96 * MiB;
static_assert(OUT_QN + 32 * MiB <= (size_t)MTOT * DM * 4, "d_out scratch map");

constexpr int CW_BAR = 4096;

constexpr int RING_BYTES = 131072;
constexpr int LDSCTL_OFF = RING_BYTES, MISC_OFF = LDSCTL_OFF + 320;
constexpr int LDS_BYTES = 147456;
constexpr int NWAVES = 8, NTHREADS = 512;

typedef __attribute__((address_space(4))) const unsigned long long kargp_t;
DI unsigned long long ldk(int i) { kargp_t* ka = (kargp_t*)__builtin_amdgcn_kernarg_segment_ptr(); asm volatile("" : "+s"(ka)); return ka[i]; }
DI const gf32* kin(int i) { return (const gf32*)ldk(i); }
DI gf32* kout() { return (gf32*)ldk(27); }
DI gu8* kws() { return (gu8*)ldk(28); }
DI int ltid() { int t = threadIdx.x; asm volatile("" : "+v"(t)); return t; }
DI int lgrid() { int g = gridDim.x; asm volatile("" : "+s"(g)); return g; }
DI int lbid() { int b = blockIdx.x; asm volatile("" : "+s"(b)); return b; }
DI float bf2f(unsigned short b) { return __uint_as_float((unsigned)b << 16); }
DI unsigned f2bf(float f) { unsigned u = __float_as_uint(f); return (u + 0x7fffu + ((u >> 16) & 1u)) >> 16; }
DI unsigned pk2(float lo, float hi) { return f2bf(lo) | (f2bf(hi) << 16); }
DI void unpack8(const u32x4 w, float (&f)[8]) {
    f[0] = __uint_as_float(w.x << 16); f[1] = __uint_as_float(w.x & 0xffff0000u); f[2] = __uint_as_float(w.y << 16); f[3] = __uint_as_float(w.y & 0xffff0000u);
    f[4] = __uint_as_float(w.z << 16); f[5] = __uint_as_float(w.z & 0xffff0000u); f[6] = __uint_as_float(w.w << 16); f[7] = __uint_as_float(w.w & 0xffff0000u);
}
DI void unpack8u(const u32x2 w, float (&f)[8]) {
    f[0] = (float)(w.x & 255u); f[1] = (float)((w.x >> 8) & 255u); f[2] = (float)((w.x >> 16) & 255u); f[3] = (float)(w.x >> 24);
    f[4] = (float)(w.y & 255u); f[5] = (float)((w.y >> 8) & 255u); f[6] = (float)((w.y >> 16) & 255u); f[7] = (float)(w.y >> 24);
}
#define QG(x) fmaxf(__builtin_rintf((x) * 255.f), 1.f)
DI u32x2 pack8gate(const float (&g)[8]) {
    u32x2 w; w.x = 0u; w.y = 0u;
    w.x = __builtin_amdgcn_cvt_pk_u8_f32(QG(g[0]), 0, w.x); w.x = __builtin_amdgcn_cvt_pk_u8_f32(QG(g[1]), 1, w.x);
    w.x = __builtin_amdgcn_cvt_pk_u8_f32(QG(g[2]), 2, w.x); w.x = __builtin_amdgcn_cvt_pk_u8_f32(QG(g[3]), 3, w.x);
    w.y = __builtin_amdgcn_cvt_pk_u8_f32(QG(g[4]), 0, w.y); w.y = __builtin_amdgcn_cvt_pk_u8_f32(QG(g[5]), 1, w.y);
    w.y = __builtin_amdgcn_cvt_pk_u8_f32(QG(g[6]), 2, w.y); w.y = __builtin_amdgcn_cvt_pk_u8_f32(QG(g[7]), 3, w.y);
    return w;
}
DI u32x4 pack8(const float (&o)[8]) { u32x4 w; w.x = pk2(o[0], o[1]); w.y = pk2(o[2], o[3]); w.z = pk2(o[4], o[5]); w.w = pk2(o[6], o[7]); return w; }
DI float sigmoidf_(float x) { return __builtin_amdgcn_rcpf(1.f + __builtin_amdgcn_exp2f(x * -LOG2E)); }
DI float wave_sum(float v) {
#pragma unroll
    for (int o = 1; o < 64; o <<= 1) v += __shfl_xor(v, o);
    return v;
}

namespace pg8 {
constexpr int BM = 256, BK = 64, HALF = 128, HTB = HALF * BK * 2, STAGE_BYTES = 8 * HTB, NXCD = 8, WGM = 4;
__host__ __device__ __forceinline__ int lds_byte(int r, int c) { const int st = (r >> 4) * 2 + (c >> 5), rr = r & 15, cc = c & 31, ob = rr * 64 + cc * 2; return st * 1024 + (ob ^ (((ob >> 9) & 1) << 5)); }
__host__ __device__ __forceinline__ void stage_rc(int b, int& R, int& C) { const int st = b / 1024, sb = b % 1024, swz = sb ^ (((sb >> 9) & 1) << 5); R = (st >> 1) * 16 + swz / 64; C = (st & 1) * 32 + (swz % 64) / 2; }
__host__ __device__ __forceinline__ int perm32(int rho) { const int n = rho >> 4, i = rho & 15; return 8 * (i >> 2) + 4 * n + (i & 3); }

DI void glds16s(unsigned voff, const void* sbase, unsigned lds_dst) { unsigned keep;
    asm volatile("s_mov_b32 %0, m0\n\ts_mov_b32 m0, %3\n\ts_nop 0\n\tglobal_load_lds_dwordx4 %1, %2\n\ts_mov_b32 m0, %0" : "=&s"(keep) : "v"(voff), "s"(sbase), "s"(lds_dst) : "memory"); }
struct Unit { int pm, pn; };
struct Gemm { const gbf16* A; const gbf16* Bt; int M, N, K, lda, ldb, apn_shift, apn_stride, atile; };

struct StaticOrder {
    int nM, nN, nwg, G, c, pn0, skip_from, skip_by, wgm;
    DI void init(int M, int N, int G_, int c_, int pn0_ = 0, int skip_from_ = 1 << 30, int skip_by_ = 0, int wgm_ = WGM) { nM = M / BM; nN = N / BM; nwg = nM * nN; G = G_; c = c_; pn0 = pn0_; skip_from = skip_from_; skip_by = skip_by_; wgm = wgm_; }
    DI bool next(int i, Unit& u) const {
        const long L = (long)i * G + c; if (L >= nwg) return false;
        int wgid = (int)L; { const int q = nwg / NXCD, r = nwg % NXCD, xcd = wgid % NXCD, off = wgid / NXCD; wgid = (xcd < r ? xcd * (q + 1) : r * (q + 1) + (xcd - r) * q) + off; }
        const int nig = wgm * nN, gid = wgid / nig, fm = gid * wgm, gsz = (nM - fm) < wgm ? (nM - fm) : wgm;
        u.pm = fm + ((wgid % nig) % gsz); int pn = pn0 + (wgid % nig) / gsz; if (pn >= skip_from) pn += skip_by; u.pn = pn; return true;
    }
};

template <class Epi, bool ALIGN_EPI>
DI void gemm_phase(LAS unsigned char* lds, const Gemm g, const StaticOrder& S, const Epi& E, int stagger = 0) {
    if (stagger > 0) { const unsigned long long t0 = __builtin_amdgcn_s_memrealtime(); const unsigned long long d = (unsigned long long)(((lbid() >> 3) & 3) * stagger);
        while (__builtin_amdgcn_s_memrealtime() - t0 < d) __builtin_amdgcn_s_sleep(8); }
    const int tid = ltid(), wid = __builtin_amdgcn_readfirstlane(tid >> 6), lane = tid & 63, wr = wid >> 2, wc = wid & 3, fr = lane & 15, fq = lane >> 4;
    const int nt = g.K / BK;
    unsigned voffA[2], voffB[2];
#pragma unroll
    for (int i = 0; i < 2; ++i) { int R, C; stage_rc(tid * 16 + i * 8192, R, C); const int Rb = Epi::PERM ? ((R & ~31) + perm32(R & 31)) : R;
        voffA[i] = (unsigned)(R * g.lda + C) * 2u; voffB[i] = (unsigned)(Rb * g.ldb + C) * 2u; }
    const size_t kstep = (size_t)(BK * 2), kstepA = g.atile ? (size_t)(BM * BK * 2) : kstep;
    const size_t hstepA = (size_t)HALF * g.lda * 2, hstepB = (size_t)HALF * g.ldb * 2;
    const size_t tstepA = g.atile ? (size_t)BM * g.K * 2 : 2 * hstepA, tstepB = 2 * hstepB;
    const unsigned ldsw = (unsigned)wid * 1024u, lds32 = (unsigned)(uintptr_t)lds;
    const int aoff = lds_byte(wr * 64 + fr, fq * 8), boff = lds_byte(wc * 32 + fr, fq * 8);
#define PG8_UA(u) ((const char*)g.A + (size_t)(u).pm * tstepA + (size_t)(((u).pn >> g.apn_shift) * g.apn_stride) * 2)
#define PG8_UB(u) ((const char*)g.Bt + (size_t)(u).pn * tstepB)
#define PG8_SA(b, h) (((b) * 2 + (h)) * HTB)
#define PG8_SB(b, h) ((4 + (b) * 2 + (h)) * HTB)
#define PG8_STAGE(bufoff, gbase, voff) do { _Pragma("unroll") for (int _i = 0; _i < 2; ++_i) \
        glds16s((voff)[_i], (const void*)(gbase), lds32 + (unsigned)(bufoff) + ldsw + (unsigned)_i * 8192u); } while (0)
#define PG8_LDA(dst, b, h) do { _Pragma("unroll") for (int m = 0; m < 4; ++m) _Pragma("unroll") for (int k = 0; k < 2; ++k) dst[m][k] = *(const LAS bf16x8*)(lds + PG8_SA(b, h) + aoff + m * 2048 + k * 1024); } while (0)
#define PG8_LDB(dst, b, h) do { _Pragma("unroll") for (int n = 0; n < 2; ++n) _Pragma("unroll") for (int k = 0; k < 2; ++k) dst[n][k] = *(const LAS bf16x8*)(lds + PG8_SB(b, h) + boff + n * 2048 + k * 1024); } while (0)
#define PG8_MMA(ai, bj, At, Bt) do { __builtin_amdgcn_s_setprio(1); _Pragma("unroll") for (int m = 0; m < 4; ++m) _Pragma("unroll") for (int n = 0; n < 2; ++n) _Pragma("unroll") for (int k = 0; k < 2; ++k) \
        acc[ai][bj][m][n] = __builtin_amdgcn_mfma_f32_16x16x32_bf16(Bt[n][k], At[m][k], acc[ai][bj][m][n], 0, 0, 0); __builtin_amdgcn_s_setprio(0); } while (0)
#define PG8_WAIT_V(n) asm volatile("s_waitcnt vmcnt(" #n ")" ::: "memory")
#define PG8_WAIT_L(n) asm volatile("s_waitcnt lgkmcnt(" #n ")" ::: "memory")
#define PG8_BAR __builtin_amdgcn_s_barrier()
#define PG8_SCHED __builtin_amdgcn_sched_barrier(0)
    Unit cur, nxt; int ui = 0;
    if (!S.next(0, cur)) return;
    f32x4 acc[2][2][4][2];
#pragma unroll
    for (int a = 0; a < 2; ++a)
#pragma unroll
        for (int b = 0; b < 2; ++b)
#pragma unroll
            for (int m = 0; m < 4; ++m)
#pragma unroll
                for (int n = 0; n < 2; ++n) acc[a][b][m][n] = (f32x4){0.f, 0.f, 0.f, 0.f};
    bf16x8 At[4][2], B0[2][2], B1[2][2];
    const char* cA = PG8_UA(cur); const char* cB = PG8_UB(cur);
    PG8_STAGE(PG8_SB(0, 0), cB, voffB); PG8_STAGE(PG8_SB(0, 1), cB + hstepB, voffB); PG8_STAGE(PG8_SA(0, 0), cA, voffA); PG8_STAGE(PG8_SA(0, 1), cA + hstepA, voffA);
    if (wr == 1) PG8_BAR;
    PG8_WAIT_V(2); PG8_BAR;
    PG8_STAGE(PG8_SB(1, 0), cB + kstep, voffB); PG8_STAGE(PG8_SA(1, 0), cA + kstepA, voffA); PG8_STAGE(PG8_SB(1, 1), cB + hstepB + kstep, voffB);
    PG8_WAIT_V(6); PG8_BAR;
    for (;;) {
        const bool has_next = S.next(ui + 1, nxt);
        const char* nA = has_next ? PG8_UA(nxt) : cA; const char* nB = has_next ? PG8_UB(nxt) : cB;
        for (int t = 0; t < nt; t += 2) {
            const bool last = (t == nt - 2);
            const char* a1 = cA + (size_t)(t + 1) * kstepA;
            const char* a2 = last ? nA : cA + (size_t)(t + 2) * kstepA; const char* b2 = last ? nB : cB + (size_t)(t + 2) * kstep;
            const char* a3 = a2 + kstepA; const char* b3 = b2 + kstep;
            PG8_LDB(B0, 0, 0); PG8_LDB(B1, 0, 1); PG8_SCHED; PG8_LDA(At, 0, 0); PG8_STAGE(PG8_SA(1, 1), a1 + hstepA, voffA);
            PG8_WAIT_V(8); PG8_WAIT_L(0); PG8_BAR; PG8_MMA(0, 0, At, B0); PG8_MMA(0, 1, At, B1); PG8_BAR; PG8_SCHED;
            PG8_LDA(At, 0, 1); PG8_STAGE(PG8_SB(0, 0), b2, voffB); PG8_STAGE(PG8_SB(0, 1), b2 + hstepB, voffB); PG8_STAGE(PG8_SA(0, 0), a2, voffA);
            PG8_WAIT_V(8); PG8_WAIT_L(0); PG8_BAR; PG8_MMA(1, 0, At, B0); PG8_MMA(1, 1, At, B1); PG8_BAR; PG8_SCHED;
            PG8_LDB(B0, 1, 0); PG8_LDB(B1, 1, 1); PG8_SCHED; PG8_LDA(At, 1, 0); PG8_STAGE(PG8_SA(0, 1), a2 + hstepA, voffA);
            PG8_WAIT_V(8); PG8_WAIT_L(0); PG8_BAR; PG8_MMA(0, 0, At, B0); PG8_MMA(0, 1, At, B1); PG8_BAR; PG8_SCHED;
            PG8_LDA(At, 1, 1); PG8_STAGE(PG8_SB(1, 0), b3, voffB); PG8_STAGE(PG8_SB(1, 1), b3 + hstepB, voffB); PG8_STAGE(PG8_SA(1, 0), a3, voffA);
            PG8_WAIT_V(8); PG8_WAIT_L(0); PG8_BAR; PG8_MMA(1, 0, At, B0); PG8_MMA(1, 1, At, B1); PG8_BAR; PG8_SCHED;
            if constexpr (Epi::MID) { if (!last && ((t + 2) & 7) == 0) E.mid(acc, cur, (t + 2) >> 3, wr, wc, fr, fq); }
        }
        if constexpr (ALIGN_EPI) { if (wr == 0) PG8_BAR; }
        E(acc, cur, wr, wc, fr, fq);
        if (!has_next) break;
#pragma unroll
        for (int a = 0; a < 2; ++a)
#pragma unroll
            for (int b = 0; b < 2; ++b)
#pragma unroll
                for (int m = 0; m < 4; ++m)
#pragma unroll
                    for (int n = 0; n < 2; ++n) acc[a][b][m][n] = (f32x4){0.f, 0.f, 0.f, 0.f};
        cur = nxt; cA = nA; cB = nB; ++ui;
        if constexpr (ALIGN_EPI) { if (wr == 1) PG8_BAR; }
    }
    PG8_WAIT_V(0);
    if constexpr (!ALIGN_EPI) { if (wr == 0) PG8_BAR; }
    PG8_BAR;
#undef PG8_UA
#undef PG8_UB
#undef PG8_SA
#undef PG8_SB
#undef PG8_STAGE
#undef PG8_LDA
#undef PG8_LDB
#undef PG8_MMA
#undef PG8_WAIT_V
#undef PG8_WAIT_L
#undef PG8_BAR
#undef PG8_SCHED
}
}

namespace epi {
using pg8::Unit;
typedef const f32x4 (&AccC)[2][2][4][2];
typedef f32x4 (&AccM)[2][2][4][2];

DI void row_rstd32(const gf32* SS, int rowb, int fq, float invn, float (&rs)[2][4]) {
#pragma unroll
    for (int ai = 0; ai < 2; ++ai)
#pragma unroll
        for (int m = 0; m < 4; ++m) {
            const gf32x4* p = (const gf32x4*)(SS + (size_t)(rowb + ai * 128 + m * 16) * 32) + fq * 2;
            const f32x4 a = p[0], b = p[1];
            float s = ((a.x + a.y) + (a.z + a.w)) + ((b.x + b.y) + (b.z + b.w));
            s += __shfl_xor(s, 16); s += __shfl_xor(s, 32);
            rs[ai][m] = rsqrtf(s * invn + EPS);
        }
}
constexpr int RSTD_CACHE_OFF = LDSCTL_OFF + 4096;
DI void row_rstd_cached(const gf32* SS, unsigned tag, int rowb, int fq, int fr, int wid, float (&rs)[2][4]) {
    LAS float* cache = (LAS float*)(uintptr_t)(RSTD_CACHE_OFF + wid * 1024);
    const unsigned have = __builtin_amdgcn_readfirstlane(((LAS unsigned*)cache)[255]);
    if (have != tag) {
        row_rstd32(SS, rowb, fq, 1.f / (float)DM, rs);
        if (fq == 0) {
#pragma unroll
            for (int ai = 0; ai < 2; ++ai)
#pragma unroll
                for (int m = 0; m < 4; ++m) cache[(ai * 4 + m) * 16 + fr] = rs[ai][m];
        }
        ((LAS unsigned*)cache)[255] = tag;
    } else {
#pragma unroll
        for (int ai = 0; ai < 2; ++ai)
#pragma unroll
            for (int m = 0; m < 4; ++m) rs[ai][m] = cache[(ai * 4 + m) * 16 + fr];
    }
}
DI size_t gate_off(int pm, int t, int wid, int slot, int lane) { return ((((size_t)(pm * 32 + t) * 8 + wid) * 16 + slot) * 64 + lane) * 8; }
DI void rope8(float (&o)[8], const gf32* tab, int fq) {
    const f32x4 c0 = *(const gf32x4*)(tab + fq * 8), c1 = *(const gf32x4*)(tab + fq * 8 + 4);
    float a, b;
    a = o[0]; b = o[1]; o[0] = a * c0.x - b * c0.y; o[1] = a * c0.y + b * c0.x;
    a = o[2]; b = o[3]; o[2] = a * c0.z - b * c0.w; o[3] = a * c0.w + b * c0.z;
    a = o[4]; b = o[5]; o[4] = a * c1.x - b * c1.y; o[5] = a * c1.y + b * c1.x;
    a = o[6]; b = o[7]; o[6] = a * c1.z - b * c1.w; o[7] = a * c1.w + b * c1.z;
}

struct EpiSwiGLU {
    static constexpr bool PERM = true, MID = false;
    unsigned uid;
    DI void operator()(AccC acc, const Unit& u, int wr, int wc, int fr, int fq) const {
        gu8* ws = kws(); gbf16* U = (gbf16*)(ws + WS_BIG); const gf32* SS = (const gf32*)(ws + WS_SS);
        const int rowb = u.pm * 256 + wr * 64 + fr; float rs[2][4]; row_rstd_cached(SS, (uid << 16) | (unsigned)(u.pm + 1), rowb, fq, fr, wr * 4 + wc, rs);
        const size_t ubase = ((size_t)(u.pm * (DFF / 64) + 2 * u.pn + (wc >> 1)) * 256 + (wr * 64 + fr)) * 64 + (wc & 1) * 32 + 8 * fq;
#pragma unroll
        for (int ai = 0; ai < 2; ++ai)
#pragma unroll
            for (int m = 0; m < 4; ++m) { const float r = rs[ai][m], r2 = r * r, rl = r * -LOG2E; float o[8];
#pragma unroll
                for (int n = 0; n < 2; ++n)
#pragma unroll
                    for (int e = 0; e < 4; ++e) { const float a = acc[ai][0][m][n][e], b = acc[ai][1][m][n][e]; o[4 * n + e] = (a * b) * r2 * __builtin_amdgcn_rcpf(1.f + __builtin_amdgcn_exp2f(a * rl)); }
                __builtin_nontemporal_store(pack8(o), (gu32x4*)(U + ubase + (size_t)(ai * 128 + m * 16) * 64)); }
    }
};

struct EpiResidual {
    static constexpr bool PERM = true, MID = false;
    int row0; float s;
    DI void operator()(AccC acc, const Unit& u, int wr, int wc, int fr, int fq) const {
        gu8* ws = kws(); gbf16* XB = (gbf16*)(ws + WS_XB); gf32* SS = (gf32*)(ws + WS_SS);
        const int rowb = row0 + u.pm * 256 + wr * 64 + fr, col = u.pn * 256 + wc * 32 + 8 * fq;
#pragma unroll
        for (int ai = 0; ai < 2; ++ai) {
            u32x4 xv[4][2];
#pragma unroll
            for (int m = 0; m < 4; ++m)
#pragma unroll
                for (int bj = 0; bj < 2; ++bj) xv[m][bj] = *(const gu32x4*)(XB + (size_t)(rowb + ai * 128 + m * 16) * DM + col + bj * 128);
#pragma unroll
            for (int m = 0; m < 4; ++m) { const int row = rowb + ai * 128 + m * 16; float ss = 0.f;
#pragma unroll
                for (int bj = 0; bj < 2; ++bj) { float x[8]; unpack8(xv[m][bj], x);
#pragma unroll
                    for (int n = 0; n < 2; ++n)
#pragma unroll
                        for (int e = 0; e < 4; ++e) x[4 * n + e] += acc[ai][bj][m][n][e] * s;
                    const u32x4 w = pack8(x); *(gu32x4*)(XB + (size_t)row * DM + col + bj * 128) = w;
                    float xr[8]; unpack8(w, xr);
#pragma unroll
                    for (int e = 0; e < 8; ++e) ss += xr[e] * xr[e]; }
                ss += __shfl_xor(ss, 16); ss += __shfl_xor(ss, 32);
                if (fq == 0) SS[(size_t)row * 32 + u.pn * 4 + wc] = ss; }
            asm volatile("" ::: "memory");
        }
    }
};

struct EpiProj {
    static constexpr bool PERM = true, MID = false;
    int row0; int Lmask; unsigned uid;
    DI void operator()(AccC acc, const Unit& u, int wr, int wc, int fr, int fq) const {
        gu8* ws = kws();
        const int rowb = u.pm * 256 + wr * 64 + fr; float rs[2][4]; row_rstd_cached((const gf32*)(ws + WS_SS) + (size_t)row0 * 32, (uid << 16) | (unsigned)(u.pm + 1), rowb, fq, fr, wr * 4 + wc, rs);
        const int pn = u.pn, colin = wc * 32 + 8 * fq;
        if (pn >= 28) {
            gu8* G = ws + WS_G;
#pragma unroll
            for (int ai = 0; ai < 2; ++ai)
#pragma unroll
                for (int m = 0; m < 4; ++m) { const float rl = rs[ai][m] * -LOG2E;
#pragma unroll
                    for (int bj = 0; bj < 2; ++bj) { float o[8];
#pragma unroll
                        for (int n = 0; n < 2; ++n)
#pragma unroll
                            for (int e = 0; e < 4; ++e) o[4 * n + e] = __builtin_amdgcn_rcpf(1.f + __builtin_amdgcn_exp2f(acc[ai][bj][m][n][e] * rl));
                        *(gu32x2*)(G + gate_off(u.pm, pn - 28, wr * 4 + wc, (ai * 4 + m) * 2 + bj, fq * 16 + fr)) = pack8gate(o); } }
        } else {
            gbf16* PROJ = (gbf16*)(ws + WS_PROJ); gf32* QSS = (gf32*)(ws + WS_QSS); gf32* KSS = (gf32*)(ws + WS_KSS); const gf32* ROPE = (const gf32*)(ws + WS_ROPE);
            const float sc = (pn < 6 || pn == 21 || pn == 22) ? 0.125f * LOG2E : 1.f;
#pragma unroll
            for (int ai = 0; ai < 2; ++ai)
#pragma unroll
                for (int m = 0; m < 4; ++m) { const int row = rowb + ai * 128 + m * 16; const float r = rs[ai][m] * sc; float sq[2];
#pragma unroll
                    for (int bj = 0; bj < 2; ++bj) { float o[8]; float q = 0.f;
#pragma unroll
                        for (int n = 0; n < 2; ++n)
#pragma unroll
                            for (int e = 0; e < 4; ++e) { const float v = acc[ai][bj][m][n][e] * r; o[4 * n + e] = v; q += v * v; }
                        sq[bj] = q;
                        if (pn == 20 && bj == 0 && wc == 0) rope8(o, ROPE + (size_t)(row & Lmask) * 32, fq);
                        *(gu32x4*)(PROJ + (size_t)row * NPROJ + pn * 256 + bj * 128 + colin) = pack8(o); }
                    if (pn == 18 || pn == 19) {
                        float a = sq[0], b = sq[1];
                        a += __shfl_xor(a, 16); a += __shfl_xor(a, 32); b += __shfl_xor(b, 16); b += __shfl_xor(b, 32);
                        if (fq == 0) { if (pn == 18) QSS[(size_t)row * 8 + wc] = a + b; else { QSS[(size_t)row * 8 + 4 + wc] = a; KSS[(size_t)row * 4 + wc] = b; } }
                    } }
        }
    }
};

struct EpiMlaQ {
    static constexpr bool PERM = true, MID = false;
    int Lmask;
    DI void operator()(AccC acc, const Unit& u, int wr, int wc, int fr, int fq) const {
        gu8* ws = kws(); gbf16* QN = (gbf16*)((gu8*)kout() + OUT_QN); gbf16* QR = (gbf16*)(ws + WS_QR); const gf32* QSS = (const gf32*)(ws + WS_QSS); const gf32* ROPE = (const gf32*)(ws + WS_ROPE);
        const float scale = 0.10206207261596577f * LOG2E;
        const int rowb = u.pm * 256 + wr * 64 + fr, colin = u.pn * 256 + wc * 32 + 8 * fq;
#pragma unroll
        for (int ai = 0; ai < 2; ++ai)
#pragma unroll
            for (int m = 0; m < 4; ++m) { const int row = rowb + ai * 128 + m * 16;
                const f32x4 a = *(const gf32x4*)(QSS + (size_t)row * 8), b = *(const gf32x4*)(QSS + (size_t)row * 8 + 4);
                const float r = rsqrtf((((a.x + a.y) + (a.z + a.w)) + ((b.x + b.y) + (b.z + b.w))) * (1.f / 384.f) + EPS) * scale;
#pragma unroll
                for (int bj = 0; bj < 2; ++bj) { float o[8];
#pragma unroll
                    for (int n = 0; n < 2; ++n)
#pragma unroll
                        for (int e = 0; e < 4; ++e) o[4 * n + e] = acc[ai][bj][m][n][e] * r;
                    if (u.pn == 2) { rope8(o, ROPE + (size_t)(row & Lmask) * 32, fq); *(gu32x4*)(QR + (size_t)row * 256 + wc * 32 + 8 * fq + bj * 128) = pack8(o); }
                    else *(gu32x4*)(QN + (size_t)row * 512 + colin + bj * 128) = pack8(o); } }
    }
};
struct EpiMlaKV {
    static constexpr bool PERM = true, MID = false;
    DI void operator()(AccC acc, const Unit& u, int wr, int wc, int fr, int fq) const {
        gu8* ws = kws(); gbf16* KVB = (gbf16*)(ws + WS_KVB); const gf32* KSS = (const gf32*)(ws + WS_KSS);
        const int rowb = u.pm * 256 + wr * 64 + fr, colin = u.pn * 256 + wc * 32 + 8 * fq;
#pragma unroll
        for (int ai = 0; ai < 2; ++ai)
#pragma unroll
            for (int m = 0; m < 4; ++m) { const int row = rowb + ai * 128 + m * 16;
                const f32x4 a = *(const gf32x4*)(KSS + (size_t)row * 4);
                const float r = rsqrtf(((a.x + a.y) + (a.z + a.w)) * (1.f / 128.f) + EPS);
#pragma unroll
                for (int bj = 0; bj < 2; ++bj) { float o[8];
#pragma unroll
                    for (int n = 0; n < 2; ++n)
#pragma unroll
                        for (int e = 0; e < 4; ++e) o[4 * n + e] = acc[ai][bj][m][n][e] * r;
                    *(gu32x4*)(KVB + (size_t)row * 1024 + colin + bj * 128) = pack8(o); } }
    }
};
struct EpiLru {
    static constexpr bool PERM = true, MID = false;
    int layer;
    DI void operator()(AccC acc, const Unit& u, int wr, int wc, int fr, int fq) const {
        gu8* ws = kws(); GAS unsigned* AU = (GAS unsigned*)((gu8*)kout() + OUT_AU); const gbf16* XC = (const gbf16*)((gu8*)kout() + OUT_XC);
        const gf32* b_a = kin(15) + layer * 1024; const gf32* b_x = kin(17) + layer * 1024; const gf32* lam = kin(18) + layer * 1024;
        const int rowb = u.pm * 256 + wr * 64 + fr, ch0 = u.pn * 64 + wc * 16 + 4 * fq;
#pragma unroll
        for (int bj = 0; bj < 2; ++bj) {
            const f32x4 ba = *(const gf32x4*)(b_a + bj * 512 + ch0), bx = *(const gf32x4*)(b_x + bj * 512 + ch0), lm = *(const gf32x4*)(lam + bj * 512 + ch0);
            float sp[4];
#pragma unroll
            for (int e = 0; e < 4; ++e) sp[e] = (-8.f * LOG2E) * log1pf(__expf(-lm[e]));
#pragma unroll
            for (int ai = 0; ai < 2; ++ai)
#pragma unroll
                for (int m = 0; m < 4; ++m) { const int row = rowb + ai * 128 + m * 16;
                    const u32x2 xw = *(const gu32x2*)(XC + (size_t)row * 512 + ch0);
                    const float xc[4] = {__uint_as_float(xw.x << 16), __uint_as_float(xw.x & 0xffff0000u), __uint_as_float(xw.y << 16), __uint_as_float(xw.y & 0xffff0000u)};
                    float o[8];
#pragma unroll
                    for (int e = 0; e < 4; ++e) { const float pr = acc[ai][bj][m][e >> 1][(e & 1) * 2], pi = acc[ai][bj][m][e >> 1][(e & 1) * 2 + 1];
                        const float r = sigmoidf_(pr + ba[e]), ig = sigmoidf_(pi + bx[e]);
                        const float a1 = __builtin_amdgcn_exp2f(r * sp[e]); o[2 * e] = 1.f - a1; o[2 * e + 1] = __builtin_amdgcn_sqrtf(fmaxf(1.f - a1 * a1, 0.f)) * (ig * xc[e]); }
                    u32x4 w; w.x = pk2(o[0], o[1]); w.y = pk2(o[2], o[3]); w.z = pk2(o[4], o[5]); w.w = pk2(o[6], o[7]);
                    *(gu32x4*)(AU + (size_t)(row * 2 + bj) * 512 + ch0) = w;
                    asm volatile("" ::: "memory"); }
        }
    }
};
struct EpiBranch {
    static constexpr bool PERM = true, MID = true;
    DI void mid(AccM acc, const Unit& u, int b, int wr, int wc, int fr, int fq) const {
        const gu8* G = kws() + WS_G;
        const int rowb = u.pm * 256 + wr * 64 + fr, col = u.pn * 256 + wc * 32 + 8 * fq;
#pragma unroll
        for (int ai = 0; ai < 2; ++ai) {
            u32x2 w0[4][2], w1[4][2];
#pragma unroll
            for (int m = 0; m < 4; ++m)
#pragma unroll
                for (int bj = 0; bj < 2; ++bj) { const int slot = (ai * 4 + m) * 2 + bj, wid = wr * 4 + wc, ln = fq * 16 + fr;
                    w0[m][bj] = *(const gu32x2*)(G + gate_off(u.pm, 8 * (b - 1) + u.pn, wid, slot, ln)); w1[m][bj] = *(const gu32x2*)(G + gate_off(u.pm, 8 * b + u.pn, wid, slot, ln)); }
#pragma unroll
            for (int m = 0; m < 4; ++m)
#pragma unroll
                for (int bj = 0; bj < 2; ++bj) { float g0[8], g1[8]; unpack8u(w0[m][bj], g0); unpack8u(w1[m][bj], g1);
#pragma unroll
                    for (int n = 0; n < 2; ++n)
#pragma unroll
                        for (int e = 0; e < 4; ++e) acc[ai][bj][m][n][e] *= g0[4 * n + e] * __builtin_amdgcn_rcpf(g1[4 * n + e]); }
        }
    }
    DI void operator()(AccC acc, const Unit& u, int wr, int wc, int fr, int fq) const {
        gu8* ws = kws(); const gu8* G = ws + WS_G; gbf16* MG = (gbf16*)(ws + WS_MG);
        const int rowb = u.pm * 256 + wr * 64 + fr, col = u.pn * 256 + wc * 32 + 8 * fq;
#pragma unroll
        for (int ai = 0; ai < 2; ++ai) {
            u32x2 w3[4][2];
#pragma unroll
            for (int m = 0; m < 4; ++m)
#pragma unroll
                for (int bj = 0; bj < 2; ++bj) w3[m][bj] = *(const gu32x2*)(G + gate_off(u.pm, 24 + u.pn, wr * 4 + wc, (ai * 4 + m) * 2 + bj, fq * 16 + fr));
#pragma unroll
            for (int m = 0; m < 4; ++m) { const int row = rowb + ai * 128 + m * 16;
#pragma unroll
                for (int bj = 0; bj < 2; ++bj) { float g3[8]; unpack8u(w3[m][bj], g3); float o[8];
#pragma unroll
                    for (int n = 0; n < 2; ++n)
#pragma unroll
                        for (int e = 0; e < 4; ++e) o[4 * n + e] = acc[ai][bj][m][n][e] * (g3[4 * n + e] * (1.f / 255.f));
                    *(gu32x4*)(MG + (size_t)row * DM + col + bj * 128) = pack8(o); } }
        }
    }
};
}

namespace att {
typedef short v4i16_t __attribute__((ext_vector_type(4)));
constexpr int KSTR64 = 144, KSTR96 = 208, VSTR = 192;
DI int crow(int r, int h) { return (r & 3) + 8 * (r >> 2) + 4 * h; }
DI s16x4 vtr(const LAS unsigned char* p) { return __builtin_bit_cast(s16x4, __builtin_amdgcn_ds_read_tr16_b64_v4i16((LAS v4i16_t*)p)); }
DI unsigned cvtpk(float lo, float hi) { typedef __bf16 bf2 __attribute__((ext_vector_type(2))); f32x2 v = {lo, hi}; bf2 b = __builtin_convertvector(v, bf2); return __builtin_bit_cast(unsigned, b); }

struct NoMask { DI float operator()(float s, int) const { return s; } };
struct BandMask {
    int kq; float slope2; int R;
    DI float operator()(float s, int koff) const { const int rel = kq + koff; const int ar = rel < 0 ? -rel : rel; return ar <= R ? s - slope2 * (float)ar : -1e30f; }
};

DI float half_max(float v) { auto rr = __builtin_amdgcn_permlane32_swap(__float_as_uint(v), __float_as_uint(v), false, false); return fmaxf(__uint_as_float(rr[0]), __uint_as_float(rr[1])); }
DI float half_sum(float v) { auto rr = __builtin_amdgcn_permlane32_swap(__float_as_uint(v), __float_as_uint(v), false, false); return __uint_as_float(rr[0]) + __uint_as_float(rr[1]); }

template <int NKS, int KSTR>
DI void ld_k(bf16x8 (&kf)[NKS], const LAS unsigned char* kt, int lane) {
    const LAS unsigned char* kp = kt + (lane & 31) * KSTR + (lane >> 5) * 16;
#pragma unroll
    for (int ks = 0; ks < NKS; ++ks) kf[ks] = *(const LAS bf16x8*)(kp + ks * 32);
}
DI void ld_v(bf16x8 (&vf)[4], const LAS unsigned char* vt, int lane) {
    const int h = lane >> 5, i16 = lane & 15, q4 = i16 >> 2, p4 = i16 & 3, g1 = (lane >> 4) & 1;
    const LAS unsigned char* vp = vt + (4 * h + q4) * VSTR + g1 * 32 + p4 * 8;
#pragma unroll
    for (int db = 0; db < 2; ++db)
#pragma unroll
        for (int st = 0; st < 2; ++st) {
            const s16x4 lo = vtr(vp + (16 * st) * VSTR + db * 64), hi = vtr(vp + (16 * st + 8) * VSTR + db * 64);
            vf[2 * db + st] = (bf16x8){lo[0], lo[1], lo[2], lo[3], hi[0], hi[1], hi[2], hi[3]};
        }
}
template <int NKS>
DI void mm_qk(f32x16& s, const bf16x8 (&kf)[NKS], const bf16x8 (&qf)[NKS]) {
#pragma unroll
    for (int r = 0; r < 16; ++r) s[r] = 0.f;
#pragma unroll
    for (int ks = 0; ks < NKS; ++ks) s = __builtin_amdgcn_mfma_f32_32x32x16_bf16(kf[ks], qf[ks], s, 0, 0, 0);
}
template <int NKS>
DI void mm_qk_acc(f32x16& s, const bf16x8 (&kf)[NKS], const bf16x8 (&qf)[NKS]) {
#pragma unroll
    for (int ks = 0; ks < NKS; ++ks) s = __builtin_amdgcn_mfma_f32_32x32x16_bf16(kf[ks], qf[ks], s, 0, 0, 0);
}
template <int R>
DI void band_init(f32x16& s, int d, int r32, int h, float nslope2) {
    const float xb = (float)(d + 4 * h - r32);
    const bool partial = (d <= -R) || (d >= R);
#pragma unroll
    for (int r = 0; r < 16; ++r) { const float ax = __builtin_fabsf(xb + (float)((r & 3) + 8 * (r >> 2))); float b = nslope2 * ax; if (partial) b = ax <= (float)R ? b : -1e30f; s[r] = b; }
}
template <bool MASKED, class Mask>
DI void sm_max(f32x16& s, f32x16 (&o)[2], float& m, float& l, int lane, const Mask& mk) {
    const int h = lane >> 5;
    float tmax = -1e30f;
#pragma unroll
    for (int r = 0; r < 16; ++r) { if (MASKED) s[r] = mk(s[r], crow(r, h)); tmax = fmaxf(tmax, s[r]); }
    tmax = half_max(tmax);
    const float mnew = fmaxf(m, tmax);
    if (__any(mnew > m + 8.f)) { const float al = __builtin_amdgcn_exp2f(m - mnew); l *= al;
#pragma unroll
        for (int r = 0; r < 16; ++r) { o[0][r] *= al; o[1][r] *= al; }
        m = mnew; }
}
template <bool MASKED>
DI void sm_exp(const f32x16& s, float m, float& l, bf16x8 (&pf)[2]) {
    float p[16]; float ps = 0.f;
#pragma unroll
    for (int r = 0; r < 16; ++r) { const float e = __builtin_amdgcn_exp2f(s[r] - m); p[r] = (!MASKED || s[r] > -1e29f) ? e : 0.f; ps += p[r]; }
    l += ps;
#pragma unroll
    for (int st = 0; st < 2; ++st) { u32x4 w; w.x = cvtpk(p[8 * st], p[8 * st + 1]); w.y = cvtpk(p[8 * st + 2], p[8 * st + 3]); w.z = cvtpk(p[8 * st + 4], p[8 * st + 5]); w.w = cvtpk(p[8 * st + 6], p[8 * st + 7]);
        pf[st] = __builtin_bit_cast(bf16x8, w); }
}
template <int NKS> DI void hint_mfma_valu() {
#pragma unroll
    for (int i = 0; i < NKS; ++i) { __builtin_amdgcn_sched_group_barrier(0x008, 1, 0); __builtin_amdgcn_sched_group_barrier(0x002, 12, 0); }
}
DI void mm_pv(f32x16 (&o)[2], const bf16x8 (&vf)[4], const bf16x8 (&pf)[2]) {
#pragma unroll
    for (int db = 0; db < 2; ++db)
#pragma unroll
        for (int st = 0; st < 2; ++st) o[db] = __builtin_amdgcn_mfma_f32_32x32x16_bf16(vf[2 * db + st], pf[st], o[db], 0, 0, 0);
}
DI void store_o(const f32x16 (&o)[2], float inv, gbf16* Orow, int h) {
#pragma unroll
    for (int db = 0; db < 2; ++db)
#pragma unroll
        for (int g4 = 0; g4 < 4; ++g4) { u32x2 w; w.x = pk2(o[db][4 * g4] * inv, o[db][4 * g4 + 1] * inv); w.y = pk2(o[db][4 * g4 + 2] * inv, o[db][4 * g4 + 3] * inv);
            *(gu32x2*)(Orow + 32 * db + 8 * g4 + 4 * h) = w; }
}

template <int R, bool SINK>
DI void banded_unit(LAS unsigned char* lds, const gbf16* Kp, const gbf16* Vp, size_t rs, int w0, int w1, bool active, const gbf16* Qp, int qw, float slope2, float sink2,
                    gbf16* Op, size_t ors, gf32* Lp, size_t lrs) {
    constexpr int VOFF = 384 * KSTR64;
    const int tid = ltid(), lane = tid & 63, r32 = lane & 31, h = lane >> 5;
    const int nrow = w1 - w0;
    bf16x8 qf[4];
    { const gbf16* qrow = Qp + (size_t)((active ? qw : 0) + r32) * rs;
#pragma unroll
      for (int ks = 0; ks < 4; ++ks) qf[ks] = *(const gbf16x8*)(qrow + 16 * ks + 8 * h); }
    for (int idx = tid; idx < nrow * 8; idx += NTHREADS) { const int i = idx >> 3, c = idx & 7;
        const u32x4 kv = *(const gu32x4*)(Kp + (size_t)(w0 + i) * rs + c * 8); const u32x4 vv = *(const gu32x4*)(Vp + (size_t)(w0 + i) * rs + c * 8);
        *(LAS u32x4*)(lds + i * KSTR64 + c * 16) = kv; *(LAS u32x4*)(lds + VOFF + i * VSTR + c * 16) = vv; }
    __syncthreads();
    if (active) {
        f32x16 o[2];
#pragma unroll
        for (int r = 0; r < 16; ++r) { o[0][r] = 0.f; o[1][r] = 0.f; }
        float m = -1e30f, l = 0.f;
        int k0 = qw - R; if (k0 < w0) k0 = w0; int k1 = qw + 32 + R; if (k1 > w1) k1 = w1;
        f32x16 sA, sB; bf16x8 kf[4], vf[4], pf[2];
        ld_k<4, KSTR64>(kf, lds + (k0 - w0) * KSTR64, lane); band_init<R>(sA, k0 - qw, r32, h, -slope2); mm_qk_acc<4>(sA, kf, qf);
        if (k0 + 32 < k1) ld_k<4, KSTR64>(kf, lds + (k0 + 32 - w0) * KSTR64, lane);
        for (int kt = k0; kt < k1; kt += 32) {
            ld_v(vf, lds + VOFF + (kt - w0) * VSTR, lane);
            sm_max<false, NoMask>(sA, o, m, l, lane, NoMask{});
            __builtin_amdgcn_sched_barrier(0);
            if (kt + 32 < k1) { band_init<R>(sB, kt + 32 - qw, r32, h, -slope2); mm_qk_acc<4>(sB, kf, qf); }
            sm_exp<false>(sA, m, l, pf);
            hint_mfma_valu<4>();
            __builtin_amdgcn_sched_barrier(0);
            if (kt + 64 < k1) ld_k<4, KSTR64>(kf, lds + (kt + 64 - w0) * KSTR64, lane);
            mm_pv(o, vf, pf);
            sA = sB;
        }
        l = half_sum(l);
        if (SINK) l += __builtin_amdgcn_exp2f(sink2 - m);
        const float inv = 1.f / l;
        store_o(o, inv, Op + (size_t)(qw + r32) * ors, h);
        if (Lp != nullptr && h == 0) Lp[(size_t)(qw + r32) * lrs] = (m + __builtin_amdgcn_logf(l)) * LN2;
    }
    __syncthreads();
}

template <bool FAST>
DI bool mla_unit(LAS unsigned char* lds, const gbf16* Kn, const gbf16* Kr, const gbf16* Vp, int L, const gbf16* Qn, const gbf16* Qr, gbf16* Op) {
    constexpr int BUF = 128 * KSTR96 + 128 * VSTR, VOFF = 128 * KSTR96;
    const int tid = ltid(), lane = tid & 63, r32 = lane & 31, h = lane >> 5, wid = tid >> 6;
    bf16x8 qf[6];
    { const gbf16* qn = Qn + (size_t)(wid * 32 + r32) * 512; const gbf16* qr = Qr + (size_t)(wid * 32 + r32) * 256;
#pragma unroll
      for (int ks = 0; ks < 4; ++ks) qf[ks] = *(const gbf16x8*)(qn + 16 * ks + 8 * h);
#pragma unroll
      for (int ks = 0; ks < 2; ++ks) qf[4 + ks] = *(const gbf16x8*)(qr + 16 * ks + 8 * h); }
    f32x16 o[2];
#pragma unroll
    for (int r = 0; r < 16; ++r) { o[0][r] = 0.f; o[1][r] = 0.f; }
    float m = -1e30f, l = 0.f;
    volatile LAS unsigned* flag = (volatile LAS unsigned*)(lds + MISC_OFF) + 20;
    if (FAST && tid == 0) flag[0] = 0u;
    u32x4 preA[5], preB[5];
    const int ns = L / 128;
#define MLA_LOAD(pre, st) do { const size_t k0_ = (size_t)(st) * 128; \
        _Pragma("unroll") for (int j = 0; j < 2; ++j) { const int idx = tid + NTHREADS * j; const size_t key = k0_ + (idx >> 3); pre[j] = *(const gu32x4*)(Kn + key * 1024 + (idx & 7) * 8); pre[3 + j] = *(const gu32x4*)(Vp + key * 1024 + (idx & 7) * 8); } \
        pre[2] = *(const gu32x4*)(Kr + (k0_ + (tid >> 2)) * NPROJ + (tid & 3) * 8); } while (0)
#define MLA_WRITE(pre, b) do { _Pragma("unroll") for (int j = 0; j < 2; ++j) { const int idx = tid + NTHREADS * j; \
            *(LAS u32x4*)(lds + (b) * BUF + (idx >> 3) * KSTR96 + (idx & 7) * 16) = pre[j]; *(LAS u32x4*)(lds + (b) * BUF + VOFF + (idx >> 3) * VSTR + (idx & 7) * 16) = pre[3 + j]; } \
        *(LAS u32x4*)(lds + (b) * BUF + (tid >> 2) * KSTR96 + 128 + (tid & 3) * 16) = pre[2]; } while (0)
#define MLA_STAGE(b) do { f32x16 sA, sB; bf16x8 kf[6], vf[4], pf[2];     \
          const LAS unsigned char* kb = lds + (b) * BUF; const LAS unsigned char* vb = lds + (b) * BUF + VOFF; \
          ld_k<6, KSTR96>(kf, kb, lane); mm_qk<6>(sA, kf, qf); ld_k<6, KSTR96>(kf, kb + 32 * KSTR96, lane); \
          _Pragma("unroll") for (int j = 0; j < 4; ++j) { \
              ld_v(vf, vb + j * 32 * VSTR, lane); \
              if (!FAST) sm_max<false, NoMask>(sA, o, m, l, lane, NoMask()); \
              else { float z_ = 0.f; asm volatile("" : "+v"(z_)); if (__any(z_ > 0.f)) { l *= 0.5f; _Pragma("unroll") for (int r_ = 0; r_ < 16; ++r_) { o[0][r_] *= 0.5f; o[1][r_] *= 0.5f; } } }     \
              __builtin_amdgcn_sched_barrier(0); \
              if (j < 3) mm_qk<6>(sB, kf, qf); \
              sm_exp<false>(sA, FAST ? 0.f : m, l, pf); \
              hint_mfma_valu<6>(); \
              __builtin_amdgcn_sched_barrier(0); \
              if (j < 2) ld_k<6, KSTR96>(kf, kb + (j + 2) * 32 * KSTR96, lane); \
              mm_pv(o, vf, pf); \
              if (j < 3) sA = sB; \
          } } while (0)
    MLA_LOAD(preA, 0); MLA_LOAD(preB, 1); MLA_WRITE(preA, 0);
    __syncthreads();
    for (int st = 0; st < ns; st += 2) {
        if (st + 2 < ns) MLA_LOAD(preA, st + 2);
        MLA_STAGE(0);
        MLA_WRITE(preB, 1);
        __syncthreads();
        if (st + 3 < ns) MLA_LOAD(preB, st + 3);
        MLA_STAGE(1);
        if (st + 2 < ns) MLA_WRITE(preA, 0);
        __syncthreads();
    }
#undef MLA_LOAD
#undef MLA_WRITE
#undef MLA_STAGE
    l = half_sum(l);
    store_o(o, 1.f / l, Op + (size_t)(wid * 32 + r32) * DM, h);
    if (!FAST) return true;
    if (!(l > 1e-30f && l < 1e30f)) flag[0] = 1u;
    __syncthreads();
    const bool ok = flag[0] == 0u;
    __syncthreads();
    return ok;
}
}

#define XB_TMO      128
#define XB_XCNT(j)  (256  + 64 * (j))
#define XB_XSUB(j)  (1280 + 64 * (j))
#define XB_XGEN(j)  (2304 + 64 * (j))
#define XB_TOP      3328
#define XB_TOPGEN   3392
#define XCD_BAR_WORDS 3456
#define XB_SPIN_CAP (1u << 20)

DI unsigned xb_ld(unsigned* p)              { return __hip_atomic_load(p, __ATOMIC_RELAXED, __HIP_MEMORY_SCOPE_AGENT); }
DI unsigned xb_add(unsigned* p, unsigned v) { return __hip_atomic_fetch_add(p, v, __ATOMIC_RELAXED, __HIP_MEMORY_SCOPE_AGENT); }
DI unsigned xb_xcc_id() { return (unsigned)__builtin_amdgcn_s_getreg((3 << 11) | 20) & 0xFu; }
#define XB_SPIN(cond, bar) do { unsigned _sp = 0; while (cond) { __builtin_amdgcn_s_sleep(1); \
    if ((++_sp & 255u) == 0u) { if (xb_ld(&(bar)[XB_TMO])) break; if (_sp > XB_SPIN_CAP) { atomicAdd(&(bar)[XB_TMO], 1u); break; } } } } while (0)

struct XcdBarrier { unsigned* bar; unsigned x; volatile LAS unsigned* st; };

DI XcdBarrier xcd_barrier_post(unsigned* bar, volatile LAS unsigned* st) {
    XcdBarrier b; b.bar = bar; b.x = xb_xcc_id(); b.st = st;
    if (threadIdx.x == 0) (void)xb_add(&bar[XB_XCNT(b.x)], 1u);
    return b;
}
DI void xcd_barrier_complete(unsigned* bar, unsigned x, unsigned& nloc, unsigned& nx) {
    const unsigned G = gridDim.x * gridDim.y * gridDim.z;
    unsigned sum, cnt, mine, sp = 0u;
    for (;;) {
        sum = 0u; cnt = 0u; mine = 0u;
#pragma unroll
        for (unsigned j = 0; j < 16; ++j) { const unsigned c = xb_ld(&bar[XB_XCNT(j)]); sum += c; cnt += (c > 0u) ? 1u : 0u; mine = (j == x) ? c : mine; }
        if (sum == G) break;
        __builtin_amdgcn_s_sleep(1);
        if ((++sp & 255u) == 0u) { if (xb_ld(&bar[XB_TMO])) break; if (sp > XB_SPIN_CAP) { atomicAdd(&bar[XB_TMO], 1u); break; } }
    }
    nloc = mine > 0u ? mine : 1u; nx = cnt > 0u ? cnt : 1u;
}
DI void xcd_barrier(const XcdBarrier& b) {
    asm volatile("s_waitcnt vmcnt(0)" ::: "memory");
    __syncthreads();
    if (threadIdx.x == 0) {
        unsigned* bar = b.bar;
        __builtin_amdgcn_s_waitcnt(0);
        unsigned nloc = b.st[0], nx = b.st[1];
        if (nloc == 0u) { xcd_barrier_complete(bar, b.x, nloc, nx); b.st[0] = nloc; b.st[1] = nx; }
        const unsigned old = xb_add(&bar[XB_XSUB(b.x)], 1u);
        const unsigned gen = old / nloc;
        if (old + 1u == (gen + 1u) * nloc) {
            __builtin_amdgcn_fence(__ATOMIC_RELEASE, "agent");
            asm volatile("s_waitcnt vmcnt(0)" ::: "memory");
            const unsigned og = xb_add(&bar[XB_TOP], 1u);
            const unsigned tg = og / nx;
            if (og + 1u == (tg + 1u) * nx) xb_add(&bar[XB_TOPGEN], 1u);
            else XB_SPIN(xb_ld(&bar[XB_TOPGEN]) == tg, bar);
            __builtin_amdgcn_fence(__ATOMIC_ACQUIRE, "agent");
            xb_add(&bar[XB_XGEN(b.x)], 1u);
            asm volatile("s_waitcnt vmcnt(0)" ::: "memory");
        } else {
            XB_SPIN(xb_ld(&bar[XB_XGEN(b.x)]) == gen, bar);
            __builtin_amdgcn_fence(__ATOMIC_ACQUIRE, "agent");
            asm volatile("s_waitcnt vmcnt(0)" ::: "memory");
        }
    }
    __syncthreads();
}

template <class Src>
DI void conv_item(const Src src, gbf16* WT, int K, int nblk, int item, LAS float* scr, int lane) {
    const int kb = item / nblk, nb = item % nblk, k0 = 64 * kb, n0 = 32 * nb;
#pragma unroll 8
    for (int i = 0; i < 32; ++i) { const int kk = 2 * i + (lane >> 5); scr[kk * 33 + (lane & 31)] = src(k0 + kk, n0 + (lane & 31)); }
    asm volatile("s_waitcnt lgkmcnt(0)" ::: "memory");
    const int c = lane & 7;
#pragma unroll
    for (int j = 0; j < 4; ++j) { const int n = (lane >> 3) + 8 * j; const LAS float* s = scr + (8 * c) * 33 + n;
        u32x4 o; o.x = pk2(s[0 * 33], s[1 * 33]); o.y = pk2(s[2 * 33], s[3 * 33]); o.z = pk2(s[4 * 33], s[5 * 33]); o.w = pk2(s[6 * 33], s[7 * 33]);
        *(gu32x4*)(WT + (size_t)(n0 + n) * K + k0 + 8 * c) = o; }
    asm volatile("s_waitcnt lgkmcnt(0)" ::: "memory");
}
template <class Src>
DI void conv_item4(const Src src, gbf16* WT, int K, int nblk, int item, LAS float* scr, int lane) {
    const int kb = item / nblk, nb = item % nblk, k0 = 64 * kb, n0 = 32 * nb;
    f32x4 v[8];
#pragma unroll
    for (int i = 0; i < 8; ++i) v[i] = src.load4(k0 + 8 * i + (lane >> 3), n0 + 4 * (lane & 7));
#pragma unroll
    for (int i = 0; i < 8; ++i) { LAS float* d = scr + (8 * i + (lane >> 3)) * 33 + 4 * (lane & 7); d[0] = v[i].x; d[1] = v[i].y; d[2] = v[i].z; d[3] = v[i].w; }
    asm volatile("s_waitcnt lgkmcnt(0)" ::: "memory");
    const int c = lane & 7;
#pragma unroll
    for (int j = 0; j < 4; ++j) { const int n = (lane >> 3) + 8 * j; const LAS float* s = scr + (8 * c) * 33 + n;
        u32x4 o; o.x = pk2(s[0 * 33], s[1 * 33]); o.y = pk2(s[2 * 33], s[3 * 33]); o.z = pk2(s[4 * 33], s[5 * 33]); o.w = pk2(s[6 * 33], s[7 * 33]);
        *(gu32x4*)(WT + (size_t)(n0 + n) * K + k0 + 8 * c) = o; }
    asm volatile("s_waitcnt lgkmcnt(0)" ::: "memory");
}
struct SrcUp { const gf32* w1; const gf32* w3; const gf32* g;
    DI float operator()(int k, int n) const { const int j = (n >> 8) * 128 + (n & 127); const uintptr_t d = (uintptr_t)w3 - (uintptr_t)w1;
        const gf32* w = (const gf32*)((uintptr_t)w1 + ((n & 128) ? d : (uintptr_t)0)); return w[(size_t)k * DFF + j] * g[k]; }
    DI f32x4 load4(int k, int n) const { const int j = (n >> 8) * 128 + (n & 127); const uintptr_t d = (uintptr_t)w3 - (uintptr_t)w1;
        const gf32* w = (const gf32*)((uintptr_t)w1 + ((n & 128) ? d : (uintptr_t)0)); return *(const gf32x4*)(w + (size_t)k * DFF + j) * g[k]; } };
struct SrcPlain { const gf32* w; int N;
    DI float operator()(int k, int n) const { return w[(size_t)k * N + n]; }
    DI f32x4 load4(int k, int n) const { return *(const gf32x4*)(w + (size_t)k * N + n); } };
struct SrcIn { const gf32* w; const gf32* g;
    DI float operator()(int k, int n) const {
        int s;
        if (n < 5120) s = n;
        else if (n < 5152) { const int j = n - 5120; s = 5120 + (j >> 1) + 16 * (j & 1); }
        else if (n < 5376) s = -1;
        else if (n < 6144) s = 5152 + (n - 5376);
        else if (n < 7168) s = 5920 + (n - 6144);
        else s = 6944 + (n - 7168);
        return s < 0 ? 0.f : w[(size_t)k * N_IN + s] * g[k]; }
    DI f32x4 load4(int k, int n) const {
        if (n >= 5120 && n < 5152) return (f32x4){(*this)(k, n), (*this)(k, n + 1), (*this)(k, n + 2), (*this)(k, n + 3)};
        if (n >= 5152 && n < 5376) return (f32x4){0.f, 0.f, 0.f, 0.f};
        const int s = n < 5120 ? n : (n < 6144 ? 5152 + (n - 5376) : (n < 7168 ? 5920 + (n - 6144) : 6944 + (n - 7168)));
        return *(const gf32x4*)(w + (size_t)k * N_IN + s) * g[k]; } };
struct SrcUq { const gf32* w; const gf32* g;
    DI float operator()(int k, int n) const { int s; if (n < 512) s = (n >> 6) * 96 + (n & 63); else { const int j = n - 512, hh = j >> 5, jj = j & 31; s = hh * 96 + 64 + (jj >> 1) + 16 * (jj & 1); }
        return w[(size_t)k * 768 + s] * g[k]; } };
struct SrcUkv { const gf32* w; const gf32* g;
    DI float operator()(int k, int n) const { if (k >= 128) return 0.f; const int s = (n < 512) ? (n >> 6) * 128 + (n & 63) : ((n - 512) >> 6) * 128 + 64 + (n & 63);
        return w[(size_t)k * 1024 + s] * g[k]; }
    DI f32x4 load4(int k, int n) const { if (k >= 128) return (f32x4){0.f, 0.f, 0.f, 0.f}; const int s = (n < 512) ? (n >> 6) * 128 + (n & 63) : ((n - 512) >> 6) * 128 + 64 + (n & 63);
        return *(const gf32x4*)(w + (size_t)k * 1024 + s) * g[k]; } };
struct SrcLru { const gf32* wa; const gf32* wx;
    DI float operator()(int k, int n) const { const int b = n >> 8, dir = (n >> 7) & 1, e = (n & 127) >> 1, jq = k >> 6, ei = k & 63; if (jq != (b & 1)) return 0.f;
        const uintptr_t d = (uintptr_t)wx - (uintptr_t)wa; const gf32* w = (const gf32*)((uintptr_t)wa + ((n & 1) ? d : (uintptr_t)0)); return w[((size_t)(dir * 8 + b) * 64 + ei) * 64 + e]; } };
struct SrcBr { const gf32* w;
    DI float operator()(int k, int n) const { return w[(size_t)k * DM + n]; }
    DI f32x4 load4(int k, int n) const { return *(const gf32x4*)(w + (size_t)k * DM + n); } };

#ifndef PH_P0
#define PH_P0 1
#endif
#ifndef PH_WCONV
#define PH_WCONV 1
#endif
#ifndef PH_M1
#define PH_M1 1
#endif
#ifndef PH_M2A
#define PH_M2A 1
#endif
#ifndef PH_M2B
#define PH_M2B 1
#endif
#ifndef PH_M2C
#define PH_M2C 1
#endif
#ifndef PH_M3
#define PH_M3 1
#endif
#ifndef PH_MX
#define PH_MX 1
#endif
#ifndef PH_S1
#define PH_S1 1
#endif
#ifndef PH_MY
#define PH_MY 1
#endif
#ifndef PH_S2
#define PH_S2 1
#endif
#ifndef PH_MZ
#define PH_MZ 1
#endif
#ifndef PH_S3
#define PH_S3 1
#endif
#ifndef PH_MERGE
#define PH_MERGE 1
#endif
#ifndef PH_M7
#define PH_M7 1
#endif
#ifndef PH_M8
#define PH_M8 1
#endif
#ifndef PH_UP
#define PH_UP 1
#endif
#ifndef PH_DN
#define PH_DN 1
#endif
#ifndef PH_FIN
#define PH_FIN 1
#endif
#ifndef REP_P0
#define REP_P0 1
#endif
#ifndef REP_WCONV
#define REP_WCONV 1
#endif
#ifndef REP_M1
#define REP_M1 1
#endif
#ifndef REP_M2A
#define REP_M2A 1
#endif
#ifndef REP_M2B
#define REP_M2B 1
#endif
#ifndef REP_M2C
#define REP_M2C 1
#endif
#ifndef REP_M3
#define REP_M3 1
#endif
#ifndef REP_MX
#define REP_MX 1
#endif
#ifndef REP_S1
#define REP_S1 1
#endif
#ifndef REP_MY
#define REP_MY 1
#endif
#ifndef REP_S2
#define REP_S2 1
#endif
#ifndef REP_MZ
#define REP_MZ 1
#endif
#ifndef REP_S3
#define REP_S3 1
#endif
#ifndef REP_MERGE
#define REP_MERGE 1
#endif
#ifndef REP_M7
#define REP_M7 1
#endif
#ifndef REP_UP
#define REP_UP 1
#endif
#ifndef REP_M8
#define REP_M8 1
#endif
#ifndef REP_DN
#define REP_DN 1
#endif
#ifndef STAG_DN
#define STAG_DN 0
#endif
#ifndef STAG_M8
#define STAG_M8 0
#endif
#ifndef STAG_M7
#define STAG_M7 0
#endif
struct Params { const float* in[27]; float* out; unsigned char* ws; };

#define GRID_BAR() do { XcdBarrier bar_; bar_.bar = (unsigned*)(kws() + WS_CTL) + CW_BAR; bar_.x = xb_xcc_id(); bar_.st = (volatile LAS unsigned*)(lds + MISC_OFF) + 8; xcd_barrier(bar_); } while (0)

__global__ void __launch_bounds__(NTHREADS, 2) trunk_fwd(Params P) {
    extern __shared__ __attribute__((aligned(16))) unsigned char lds_raw[];
    LAS unsigned char* lds = (LAS unsigned char*)lds_raw;
    (void)P;
    {
        const int tid = ltid();
        for (int u = tid; u < (LDS_BYTES - LDSCTL_OFF) / 4; u += NTHREADS) ((LAS unsigned*)(lds + LDSCTL_OFF))[u] = 0u;
        __syncthreads();
        (void)xcd_barrier_post((unsigned*)(kws() + WS_CTL) + CW_BAR, (volatile LAS unsigned*)(lds + MISC_OFF) + 8);
    }

#if PH_P0
    _Pragma("unroll 1") for (int rep_ = 0; rep_ < REP_P0; ++rep_) {
        const int tid = ltid(), lane = tid & 63, wave = tid >> 6, G = lgrid(), bid = lbid();
        gu8* ws = kws(); gbf16* XB = (gbf16*)(ws + WS_XB); gf32* SS = (gf32*)(ws + WS_SS); gf32* ROPE = (gf32*)(ws + WS_ROPE);
        const gf32* xp = kin(0); const gf32* xs = kin(1);
        for (int i = bid * NTHREADS + tid; i < 4096 * 16; i += G * NTHREADS) { const int pos = i >> 4, j = i & 15;
            const float inv = __builtin_amdgcn_exp2f(-(float)j * (13.287712379549449f / 16.f));
            const float ang = (float)pos * inv;
            double rev = (double)ang * 0.15915494309189535; rev -= (double)(long long)rev;
            ROPE[2 * i] = __builtin_amdgcn_cosf((float)rev); ROPE[2 * i + 1] = __builtin_amdgcn_sinf((float)rev); }
        for (int r = bid * NWAVES + wave; r < MTOT; r += G * NWAVES) {
            const gf32* src = (r < M_PROMPT) ? xp + (size_t)r * DM : xs + (size_t)(r - M_PROMPT) * DM;
            const gf32x4* xr = (const gf32x4*)src + lane; gu32x2* bo = (gu32x2*)(XB + (size_t)r * DM) + lane; float s = 0.f;
#pragma unroll
            for (int j = 0; j < 8; ++j) { const f32x4 v = xr[64 * j]; u32x2 w; w.x = pk2(v.x, v.y); w.y = pk2(v.z, v.w); bo[64 * j] = w;
                const float a0 = __uint_as_float(w.x << 16), a1 = __uint_as_float(w.x & 0xffff0000u), a2 = __uint_as_float(w.y << 16), a3 = __uint_as_float(w.y & 0xffff0000u); s += (a0 * a0 + a1 * a1) + (a2 * a2 + a3 * a3); }
            s = wave_sum(s);
            if (lane < 32) SS[(size_t)r * 32 + lane] = (lane == 0) ? s : 0.f;
        }
    }
#endif

#pragma unroll 1
    for (int layer = 0; layer < DEPTH; ++layer) {
#if PH_WCONV
        _Pragma("unroll 1") for (int rep_ = 0; rep_ < REP_WCONV; ++rep_) {
            const int tid = ltid(), lane = tid & 63, wave = tid >> 6, G = lgrid(), bid = lbid();
            LAS float* scr = (LAS float*)(lds + wave * 16384);
            gu8* ws = kws();
            const size_t wsz = (size_t)DM * DFF;
            constexpr int I_UP = (DM / 64) * (11264 / 32), I_DN = (DFF / 64) * (DM / 32), I_IN = (DM / 64) * (NIN_PAD / 32), I_SQ = (DM / 64) * (DM / 32);
            constexpr int I_UQ = (384 / 64) * (768 / 32), I_UKV = (128 / 64) * (1024 / 32), I_LRU = (128 / 64) * (2048 / 32);
            constexpr int NITEMS = 2 * I_UP + 2 * I_DN + I_IN + 2 * I_SQ + I_UQ + I_UKV + I_LRU;
#pragma unroll 1
            for (int it = bid * NWAVES + wave; it < NITEMS; it += G * NWAVES) {
                int r = it;
                if (r < I_UP) { const SrcUp s{kin(3) + layer * wsz, kin(4) + layer * wsz, kin(2) + layer * DM}; conv_item4(s, (gbf16*)(ws + WS_WUP), DM, 11264 / 32, r, scr, lane); continue; } r -= I_UP;
                if (r < I_UP) { const SrcUp s{kin(23) + layer * wsz, kin(24) + layer * wsz, kin(22) + layer * DM}; conv_item4(s, (gbf16*)(ws + WS_WUP) + (size_t)11264 * DM, DM, 11264 / 32, r, scr, lane); continue; } r -= I_UP;
                if (r < I_DN) { const SrcPlain s{kin(5) + layer * wsz, DM}; conv_item4(s, (gbf16*)(ws + WS_WDN), DFF, DM / 32, r, scr, lane); continue; } r -= I_DN;
                if (r < I_DN) { const SrcPlain s{kin(25) + layer * wsz, DM}; conv_item4(s, (gbf16*)(ws + WS_WDN) + (size_t)DM * DFF, DFF, DM / 32, r, scr, lane); continue; } r -= I_DN;
                if (r < I_IN) { const SrcIn s{kin(7) + (size_t)layer * DM * N_IN, kin(6) + layer * DM}; conv_item4(s, (gbf16*)(ws + WS_WIN), DM, NIN_PAD / 32, r, scr, lane); continue; } r -= I_IN;
                if (r < I_SQ) { const SrcBr s{kin(20) + (size_t)layer * 4 * 512 * DM}; conv_item4(s, (gbf16*)(ws + WS_WBR), DM, DM / 32, r, scr, lane); continue; } r -= I_SQ;
                if (r < I_SQ) { const SrcPlain s{kin(21) + (size_t)layer * DM * DM, DM}; conv_item4(s, (gbf16*)(ws + WS_WOUT), DM, DM / 32, r, scr, lane); continue; } r -= I_SQ;
                if (r < I_UQ) { const SrcUq s{kin(9) + (size_t)layer * 384 * 768, kin(8) + layer * 384}; conv_item(s, (gbf16*)(ws + WS_WUQ), 384, 768 / 32, r, scr, lane); continue; } r -= I_UQ;
                if (r < I_UKV) { const SrcUkv s{kin(11) + (size_t)layer * 128 * 1024, kin(10) + layer * 128}; conv_item4(s, (gbf16*)(ws + WS_WUKV), 128, 1024 / 32, r, scr, lane); continue; } r -= I_UKV;
                { const SrcLru s{kin(14) + (size_t)layer * 2 * 8 * 64 * 64, kin(16) + (size_t)layer * 2 * 8 * 64 * 64}; conv_item(s, (gbf16*)(ws + WS_WLRU), 128, 2048 / 32, r, scr, lane); }
            }
        }
#endif
        GRID_BAR();

#pragma unroll 1
        for (int f = 0; f < 2; ++f) {
            if (f == 1) {
#pragma unroll 1
                for (int ch = 0; ch < NCHUNK; ++ch) {
                    const int row0 = ch ? M_PROMPT : 0, mc = ch ? M_SAMPLE : M_PROMPT; const int L = ch ? 4096 : 2048; const int nseq = mc / L;
#if PH_M1
                    _Pragma("unroll 1") for (int rep_ = 0; rep_ < REP_M1; ++rep_) {
                        gu8* ws = kws();
                        pg8::Gemm g{(const gbf16*)(ws + WS_XB) + (size_t)row0 * DM, (const gbf16*)(ws + WS_WIN), mc, NIN_PAD, DM, DM, DM, 0, 0, 0}; pg8::StaticOrder S; S.init(mc, NIN_PAD, lgrid(), lbid());
                        epi::EpiProj E{row0, L - 1, (unsigned)(layer * 16 + 2 + ch)};
                        pg8::gemm_phase<epi::EpiProj, true>(lds, g, S, E);
                    }
#endif
                    GRID_BAR();
#if PH_M3
                    _Pragma("unroll 1") for (int rep_ = 0; rep_ < REP_M3; ++rep_) {
                        gu8* ws = kws();
                        pg8::Gemm g{(const gbf16*)((gu8*)kout() + OUT_XC), (const gbf16*)(ws + WS_WLRU), mc, 2048, 128, 512, 128, 1, 128, 0}; pg8::StaticOrder S; S.init(mc, 2048, lgrid(), lbid());
                        {
                            const int tid = ltid(); const gbf16* PROJ = (const gbf16*)(ws + WS_PROJ); gbf16* XC = (gbf16*)((gu8*)kout() + OUT_XC);
                            const gf32* cw = kin(12) + layer * 4 * 512; const gf32* cb = kin(13) + layer * 512;
#pragma unroll 1
                            for (int i = 0; ; ++i) { pg8::Unit u; if (!S.next(i, u)) break;
                                const int c8 = (u.pn >> 1) * 128 + (tid & 15) * 8;
                                float wv[4][8], bv[8];
                                { const f32x4 b0 = *(const gf32x4*)(cb + c8), b1 = *(const gf32x4*)(cb + c8 + 4); bv[0] = b0.x; bv[1] = b0.y; bv[2] = b0.z; bv[3] = b0.w; bv[4] = b1.x; bv[5] = b1.y; bv[6] = b1.z; bv[7] = b1.w; }
#pragma unroll
                                for (int tap = 0; tap < 4; ++tap) { const f32x4 w0 = *(const gf32x4*)(cw + tap * 512 + c8), w1 = *(const gf32x4*)(cw + tap * 512 + c8 + 4);
                                    wv[tap][0] = w0.x; wv[tap][1] = w0.y; wv[tap][2] = w0.z; wv[tap][3] = w0.w; wv[tap][4] = w1.x; wv[tap][5] = w1.y; wv[tap][6] = w1.z; wv[tap][7] = w1.w; }
#pragma unroll 4
                                for (int k = 0; k < 8; ++k) { const int row = u.pm * 256 + (tid >> 4) + 32 * k, pos = row & (L - 1);
                                    u32x4 xw[4];
#pragma unroll
                                    for (int tap = 0; tap < 4; ++tap) { const int p2 = pos + tap - 2; int rr = row + tap - 2; if (p2 < 0 || p2 >= L) rr = row; xw[tap] = *(const gu32x4*)(PROJ + (size_t)rr * NPROJ + PC_XR + c8); }
                                    float a[8];
#pragma unroll
                                    for (int e = 0; e < 8; ++e) a[e] = bv[e];
#pragma unroll
                                    for (int tap = 0; tap < 4; ++tap) { const int p2 = pos + tap - 2; float xv[8]; unpack8(xw[tap], xv); const float msk = (p2 >= 0 && p2 < L) ? 1.f : 0.f;
#pragma unroll
                                        for (int e = 0; e < 8; ++e) a[e] += (xv[e] * msk) * wv[tap][e]; }
                                    *(gu32x4*)(XC + (size_t)row * 512 + c8) = pack8(a); } }
                            __syncthreads();
                        }
                        epi::EpiLru E{layer};
                        pg8::gemm_phase<epi::EpiLru, true>(lds, g, S, E);
#if PH_S1
                        {
                            const int tid = ltid(), fb = tid >> 6, cl = tid & 63; const int NSB = L / 1024;
                            const GAS unsigned* AU2 = (const GAS unsigned*)((gu8*)kout() + OUT_AU); gf32x2* SUMF = (gf32x2*)(ws + WS_SUMF); gf32x2* SUMB = (gf32x2*)(ws + WS_SUMB);
                            gf32x2* CSF = (gf32x2*)(ws + WS_CSF); gf32x2* CSB = (gf32x2*)(ws + WS_CSB);
                            LAS f32x4* xch = (LAS f32x4*)lds;
                            __syncthreads();
#pragma unroll 1
                            for (int i = 0; ; ++i) { pg8::Unit u; if (!S.next(i, u)) break;
                                const int c = u.pn * 64 + cl, blk = u.pm * 8 + fb; const GAS unsigned* au = AU2 + (size_t)blk * 32 * 1024 + c;
                                float Pf = 1.f, Hf = 0.f, Pb = 1.f, Hb = 0.f;
#pragma unroll
                                for (int t = 0; t < 32; ++t) { const unsigned w = au[(size_t)t * 1024]; const float a = 1.f - __uint_as_float(w << 16), uu = __uint_as_float(w & 0xffff0000u); Hf = a * Hf + uu; Pf *= a; }
#pragma unroll
                                for (int t = 31; t >= 0; --t) { const unsigned w = au[(size_t)t * 1024 + 512]; const float a = 1.f - __uint_as_float(w << 16), uu = __uint_as_float(w & 0xffff0000u); Hb = a * Hb + uu; Pb *= a; }
                                SUMF[(size_t)blk * 512 + c] = (f32x2){Pf, Hf}; SUMB[(size_t)blk * 512 + c] = (f32x2){Pb, Hb};
                                xch[fb * 64 + cl] = (f32x4){Pf, Hf, Pb, Hb};
                                __syncthreads();
                                if ((fb & (NSB - 1)) == 0) { float Pcf = 1.f, Hcf = 0.f, Pcb = 1.f, Hcb = 0.f;
#pragma unroll 1
                                    for (int k = 0; k < NSB; ++k) { const f32x4 e = xch[(fb + k) * 64 + cl]; Hcf = e.x * Hcf + e.y; Pcf *= e.x; }
#pragma unroll 1
                                    for (int k = NSB - 1; k >= 0; --k) { const f32x4 e = xch[(fb + k) * 64 + cl]; Hcb = e.z * Hcb + e.w; Pcb *= e.z; }
                                    const int cbk = blk / NSB; CSF[(size_t)cbk * 512 + c] = (f32x2){Pcf, Hcf}; CSB[(size_t)cbk * 512 + c] = (f32x2){Pcb, Hcb}; }
                                __syncthreads(); }
                        }
#endif
                    }
#endif
#if PH_M2B
                    _Pragma("unroll 1") for (int rep_ = 0; rep_ < REP_M2B; ++rep_) {
                        gu8* ws = kws();
                        pg8::Gemm g{(const gbf16*)(ws + WS_PROJ) + PC_CQ, (const gbf16*)(ws + WS_WUQ), mc, 768, 384, NPROJ, 384, 0, 0, 0}; pg8::StaticOrder S; S.init(mc, 768, lgrid(), lbid());
                        epi::EpiMlaQ E{L - 1};
                        pg8::gemm_phase<epi::EpiMlaQ, true>(lds, g, S, E);
                    }
#endif
#if PH_M2C
                    _Pragma("unroll 1") for (int rep_ = 0; rep_ < REP_M2C; ++rep_) {
                        gu8* ws = kws();
                        pg8::Gemm g{(const gbf16*)(ws + WS_PROJ) + PC_CKV, (const gbf16*)(ws + WS_WUKV), mc, 1024, 128, NPROJ, 128, 0, 0, 0}; pg8::StaticOrder S; S.init(mc, 1024, lgrid(), (lbid() + 192) % lgrid());
                        epi::EpiMlaKV E{};
                        pg8::gemm_phase<epi::EpiMlaKV, true>(lds, g, S, E);
                    }
#endif
#if PH_MY
                    _Pragma("unroll 1") for (int rep_ = 0; rep_ < REP_MY; ++rep_) {
                        const int tid = ltid(), wave = __builtin_amdgcn_readfirstlane(tid >> 6), G = lgrid(), bid = lbid();
                        gu8* ws = kws(); const gbf16* PROJ = (const gbf16*)(ws + WS_PROJ); gbf16* OA = (gbf16*)((gu8*)kout() + OUT_OA); gf32* LSE = (gf32*)(ws + WS_LSE);
                        int ubase = 0;
#pragma unroll 1
                        for (int gi = 0; gi < 3; ++gi) {
                            const int dil = (gi == 0) ? 1 : (gi == 1 ? 4 : 16); const int Lv = L / dil; const int QBR = Lv < 256 ? Lv : 256; const int nqb = Lv / QBR, nvs = nseq * dil;
                            const int nun = 8 * nvs * nqb;
                            int first = (bid - ubase) % G; if (first < 0) first += G;
                            const bool xo = (G % 8 == 0) && (nun % G == 0);
                            const int u_first = xo ? (bid & 7) * (nun >> 3) + (bid >> 3) : first, u_step = xo ? (G >> 3) : G, u_end = xo ? ((bid & 7) + 1) * (nun >> 3) : nun;
#pragma unroll 1
                            for (int ui = u_first; ui < u_end; ui += u_step) { const int qb = ui % nqb, vs = (ui / nqb) % nvs, hd = ui / (nqb * nvs); const int sq = vs / dil, res = vs % dil;
                                const size_t base = (size_t)sq * L + res;
                                const int q0 = qb * QBR; int w0 = q0 - 64; if (w0 < 0) w0 = 0; int w1 = q0 + QBR + 64; if (w1 > Lv) w1 = Lv;
                                const int qw = q0 + wave * 32; const bool active = wave * 32 < QBR;
                                att::banded_unit<64, false>(lds, PROJ + base * NPROJ + PC_AK + gi * 512 + hd * 64, PROJ + base * NPROJ + PC_AV + gi * 512 + hd * 64, (size_t)dil * NPROJ, w0, w1, active,
                                                            PROJ + base * NPROJ + PC_AQ + gi * 512 + hd * 64, qw, exp2f(-(float)(hd + 1)) * (float)dil * LOG2E, 0.f,
                                                            OA + ((size_t)gi * mc + base) * 512 + hd * 64, (size_t)dil * 512, LSE + ((size_t)gi * mc + base) * 8 + hd, (size_t)dil * 8); }
                            ubase += nun;
                        }
                    }
#endif
                    GRID_BAR();
#if PH_MX
                    _Pragma("unroll 1") for (int rep_ = 0; rep_ < REP_MX; ++rep_) {
                        const int G = lgrid(), bid = lbid();
                        gu8* ws = kws(); const gbf16* PROJ = (const gbf16*)(ws + WS_PROJ); const gbf16* KVB = (const gbf16*)(ws + WS_KVB); const gbf16* QN = (const gbf16*)((gu8*)kout() + OUT_QN); const gbf16* QR = (const gbf16*)(ws + WS_QR); gbf16* Y = (gbf16*)((gu8*)kout() + OUT_Y);
                        const int nqb = L / 256, nunits = nseq * 8 * nqb;
                        const bool xo = (G % 8 == 0) && (nunits % 8 == 0); const int upx = nunits / 8;
                        const int u_first = xo ? (bid & 7) * upx + (bid >> 3) : bid, u_step = xo ? (G >> 3) : G, u_end = xo ? ((bid & 7) + 1) * upx : nunits;
#pragma unroll 1
                        for (int ui = u_first; ui < u_end; ui += u_step) { const int qb = ui % nqb, hd = (ui / nqb) & 7, sq = ui / (nqb * 8);
                            const size_t srow = (size_t)sq * L, qrow = srow + (size_t)qb * 256;
                            if (!att::mla_unit<true>(lds, KVB + srow * 1024 + hd * 64, PROJ + srow * NPROJ + PC_KR, KVB + srow * 1024 + 512 + hd * 64, L,
                                                     QN + qrow * 512 + hd * 64, QR + qrow * 256 + hd * 32, Y + qrow * DM + 512 + hd * 64))
                                att::mla_unit<false>(lds, KVB + srow * 1024 + hd * 64, PROJ + srow * NPROJ + PC_KR, KVB + srow * 1024 + 512 + hd * 64, L,
                                                     QN + qrow * 512 + hd * 64, QR + qrow * 256 + hd * 32, Y + qrow * DM + 512 + hd * 64);
                            __syncthreads(); }
                    }
#endif
#if PH_MZ
                    _Pragma("unroll 1") for (int rep_ = 0; rep_ < REP_MZ; ++rep_) {
                        const int tid = ltid(), wave = __builtin_amdgcn_readfirstlane(tid >> 6), G = lgrid(), bid = lbid();
                        gu8* ws = kws(); const gbf16* PROJ = (const gbf16*)(ws + WS_PROJ); gbf16* Y = (gbf16*)((gu8*)kout() + OUT_Y);
                        const int nqb = L / 64, nunits = nseq * 2 * nqb;
                        const gf32* sink = kin(19) + layer * 8;
                        const bool xo = (G % 8 == 0) && (nunits % G == 0);
                        const int u_first = xo ? (bid & 7) * (nunits >> 3) + (bid >> 3) : bid, u_step = xo ? (G >> 3) : G, u_end = xo ? ((bid & 7) + 1) * (nunits >> 3) : nunits;
#pragma unroll 1
                        for (int ui = u_first; ui < u_end; ui += u_step) { const int qb = ui % nqb, kvh = (ui / nqb) & 1, sq = ui / (nqb * 2);
                            const size_t base = (size_t)sq * L; const int q0 = qb * 64; int w0 = q0 - 128; if (w0 < 0) w0 = 0; int w1 = q0 + 64 + 128; if (w1 > L) w1 = L;
                            const int qh = kvh * 4 + (wave >> 1), qw = q0 + (wave & 1) * 32;
                            att::banded_unit<128, true>(lds, PROJ + base * NPROJ + PC_C + 512 + kvh * 64, PROJ + base * NPROJ + PC_C + 640 + kvh * 64, (size_t)NPROJ, w0, w1, true,
                                                        PROJ + base * NPROJ + PC_C + qh * 64, qw, exp2f(-(float)(qh + 1)) * LOG2E, sink[qh] * LOG2E,
                                                        Y + base * DM + 1024 + qh * 64, (size_t)DM, nullptr, 0); }
                    }
#endif
#if PH_MERGE
                    _Pragma("unroll 1") for (int rep_ = 0; rep_ < REP_MERGE; ++rep_) {
                        const int tid = ltid(), G = lgrid(), bid = lbid();
                        gu8* ws = kws(); gbf16* Y = (gbf16*)((gu8*)kout() + OUT_Y); const gbf16* OA = (const gbf16*)((gu8*)kout() + OUT_OA); const gf32* LSE = (const gf32*)(ws + WS_LSE);
                        for (int idx = bid * NTHREADS + tid; idx < mc * 64; idx += G * NTHREADS) { const int row = idx >> 6, hd = (idx >> 3) & 7, c8 = (idx & 63) * 8;
                            const float l0 = LSE[(size_t)row * 8 + hd], l1 = LSE[((size_t)mc + row) * 8 + hd], l2 = LSE[((size_t)2 * mc + row) * 8 + hd];
                            const float mx = fmaxf(l0, fmaxf(l1, l2)); float e0 = __expf(l0 - mx), e1 = __expf(l1 - mx), e2 = __expf(l2 - mx); const float inv = 1.f / (e0 + e1 + e2); e0 *= inv; e1 *= inv; e2 *= inv;
                            float a0[8], a1[8], a2[8]; unpack8(*(const gu32x4*)(OA + (size_t)row * 512 + c8), a0); unpack8(*(const gu32x4*)(OA + ((size_t)mc + row) * 512 + c8), a1); unpack8(*(const gu32x4*)(OA + ((size_t)2 * mc + row) * 512 + c8), a2);
                            float o[8];
#pragma unroll
                            for (int e = 0; e < 8; ++e) o[e] = e0 * a0[e] + e1 * a1[e] + e2 * a2[e];
                            *(gu32x4*)(Y + (size_t)row * DM + c8) = pack8(o); }
                    }
#endif
#if PH_S3
                    _Pragma("unroll 1") for (int rep_ = 0; rep_ < REP_S3; ++rep_) {
                        const int tid = ltid(), G = lgrid(), bid = lbid();
                        gu8* ws = kws(); const gbf16* PROJ = (const gbf16*)(ws + WS_PROJ); gbf16* Y = (gbf16*)((gu8*)kout() + OUT_Y);
                        const GAS unsigned* AU2 = (const GAS unsigned*)((gu8*)kout() + OUT_AU); const gf32x2* SUMF = (const gf32x2*)(ws + WS_SUMF); const gf32x2* SUMB = (const gf32x2*)(ws + WS_SUMB);
                        const gf32x2* CSF = (const gf32x2*)(ws + WS_CSF); const gf32x2* CSB = (const gf32x2*)(ws + WS_CSB);
                        const int NC = L / 32, NSB = L / 1024;
                        for (int idx = bid * NTHREADS + tid; idx < (mc / 32) * 512; idx += G * NTHREADS) { const int c = idx & 511, blk = idx >> 9, tc = blk & (NC - 1), sblk = blk - tc;
                            const int cq = tc / NSB, cb0 = (sblk / NSB), fb0 = sblk + cq * NSB;
                            const GAS unsigned* au = AU2 + (size_t)blk * 32 * 1024 + c;
                            unsigned wf[32], wb[32]; bf16_t gt[32];
#pragma unroll
                            for (int t = 0; t < 32; ++t) wf[t] = au[(size_t)t * 1024];
#pragma unroll
                            for (int t = 0; t < 32; ++t) wb[t] = au[(size_t)t * 1024 + 512];
#pragma unroll
                            for (int t = 0; t < 32; ++t) gt[t] = PROJ[((size_t)blk * 32 + t) * NPROJ + PC_GT + c];
                            float hcur = 0.f;
#pragma unroll 8
                            for (int k = 0; k < cq; ++k) { const f32x2 e = CSF[(size_t)(cb0 + k) * 512 + c]; hcur = e.x * hcur + e.y; }
#pragma unroll 1
                            for (int k = fb0; k < blk; ++k) { const f32x2 e = SUMF[(size_t)k * 512 + c]; hcur = e.x * hcur + e.y; }
                            float hf[32];
#pragma unroll
                            for (int t = 0; t < 32; ++t) { const unsigned w = wf[t]; hcur = (1.f - __uint_as_float(w << 16)) * hcur + __uint_as_float(w & 0xffff0000u); hf[t] = hcur; }
                            hcur = 0.f;
#pragma unroll 8
                            for (int k = 31; k > cq; --k) { const f32x2 e = CSB[(size_t)(cb0 + k) * 512 + c]; hcur = e.x * hcur + e.y; }
#pragma unroll 1
                            for (int k = fb0 + NSB - 1; k > blk; --k) { const f32x2 e = SUMB[(size_t)k * 512 + c]; hcur = e.x * hcur + e.y; }
#pragma unroll
                            for (int t = 31; t >= 0; --t) { const unsigned w = wb[t]; hcur = (1.f - __uint_as_float(w << 16)) * hcur + __uint_as_float(w & 0xffff0000u);
                                const size_t row = (size_t)blk * 32 + t; const float gx = bf2f(gt[t]);
                                const float ge = gx * __builtin_amdgcn_rcpf(1.f + __builtin_amdgcn_exp2f((-2.f * LOG2E * 0.7978845608028654f) * (gx + 0.044715f * gx * gx * gx)));
                                Y[row * DM + 1536 + c] = (bf16_t)f2bf((hf[t] + hcur) * ge); } }
                    }
#endif
                    GRID_BAR();
#if PH_M7
                    _Pragma("unroll 1") for (int rep_ = 0; rep_ < REP_M7; ++rep_) {
                        gu8* ws = kws();
                        pg8::Gemm g{(const gbf16*)((gu8*)kout() + OUT_Y), (const gbf16*)(ws + WS_WBR), mc, DM, DM, DM, DM, 0, 0, 0}; pg8::StaticOrder S; S.init(mc, DM, lgrid(), lbid());
                        epi::EpiBranch E{};
                        pg8::gemm_phase<epi::EpiBranch, true>(lds, g, S, E, STAG_M7);
                    }
#endif
                    GRID_BAR();
#if PH_M8
                    _Pragma("unroll 1") for (int rep_ = 0; rep_ < REP_M8; ++rep_) {
                        gu8* ws = kws();
                        pg8::Gemm g{(const gbf16*)(ws + WS_MG), (const gbf16*)(ws + WS_WOUT), mc, DM, DM, DM, DM, 0, 0, 0}; pg8::StaticOrder S; S.init(mc, DM, lgrid(), lbid());
                        epi::EpiResidual E{row0, rep_ == REP_M8 - 1 ? 1.0f : 0.0f};
                        pg8::gemm_phase<epi::EpiResidual, true>(lds, g, S, E, STAG_M8);
                    }
#endif
                    GRID_BAR();
                }
            }
#if PH_UP
            _Pragma("unroll 1") for (int rep_ = 0; rep_ < REP_UP; ++rep_) {
                gu8* ws = kws();
                pg8::Gemm g{(const gbf16*)(ws + WS_XB), (const gbf16*)(ws + WS_WUP) + (size_t)f * 11264 * DM, MTOT, 11264, DM, DM, DM, 0, 0, 0}; pg8::StaticOrder S; S.init(MTOT, 11264, lgrid(), lbid(), 0, 1 << 30, 0, 8);
                epi::EpiSwiGLU E{(unsigned)(layer * 16 + 1 + 8 * f)};
                pg8::gemm_phase<epi::EpiSwiGLU, true>(lds, g, S, E);
            }
#endif
            GRID_BAR();
#if PH_DN
            _Pragma("unroll 1") for (int rep_ = 0; rep_ < REP_DN; ++rep_) {
                gu8* ws = kws();
                pg8::Gemm g{(const gbf16*)(ws + WS_BIG), (const gbf16*)(ws + WS_WDN) + (size_t)f * DM * DFF, MTOT, DM, DFF, 64, DFF, 0, 0, 1}; pg8::StaticOrder S; S.init(MTOT, DM, lgrid(), lbid());
                epi::EpiResidual E{0, rep_ == REP_DN - 1 ? 0.5f : 0.0f};
                pg8::gemm_phase<epi::EpiResidual, true>(lds, g, S, E, STAG_DN);
            }
#endif
            GRID_BAR();
        }
    }
#if PH_FIN
    {
        const int tid = ltid(), lane = tid & 63, wave = tid >> 6, G = lgrid(), bid = lbid();
        gu8* ws = kws(); gf32* X = kout(); const gf32* SS = (const gf32*)(ws + WS_SS); const gbf16* XB = (const gbf16*)(ws + WS_XB);
        const gf32* gn = kin(26);
        const unsigned tmo = __hip_atomic_load((unsigned*)(ws + WS_CTL) + CW_BAR + XB_TMO, __ATOMIC_RELAXED, __HIP_MEMORY_SCOPE_AGENT);
        for (int r = (bid * NWAVES + wave) * 2; r < MTOT; r += G * NWAVES * 2) {
            u32x2 w[2][8];
#pragma unroll
            for (int q = 0; q < 2; ++q) { const gu32x2* bi = (const gu32x2*)(XB + (size_t)(r + q) * DM) + lane;
#pragma unroll
                for (int j = 0; j < 8; ++j) w[q][j] = bi[64 * j]; }
            float s0 = (lane < 32) ? SS[(size_t)r * 32 + lane] : 0.f, s1 = (lane < 32) ? SS[(size_t)(r + 1) * 32 + lane] : 0.f; s0 = wave_sum(s0); s1 = wave_sum(s1);
            float rstd[2] = {rsqrtf(s0 * (1.f / (float)DM) + EPS), rsqrtf(s1 * (1.f / (float)DM) + EPS)}; if (tmo != 0u) { rstd[0] = __builtin_nanf(""); rstd[1] = rstd[0]; }
            const gf32x4* gp = (const gf32x4*)gn + lane;
#pragma unroll
            for (int j = 0; j < 8; ++j) { const f32x4 gg = gp[64 * j];
#pragma unroll
                for (int q = 0; q < 2; ++q) { gf32x4* xo = (gf32x4*)(X + (size_t)(r + q) * DM) + lane;
                    const f32x4 v = (f32x4){__uint_as_float(w[q][j].x << 16), __uint_as_float(w[q][j].x & 0xffff0000u), __uint_as_float(w[q][j].y << 16), __uint_as_float(w[q][j].y & 0xffff0000u)};
                    __builtin_nontemporal_store(v * rstd[q] * gg, xo + 64 * j); } }
        }
    }
#endif
}

extern "C" void kernel_launch(void* const* d_in, const int* in_sizes, int n_in, void* d_out, int out_size, void* d_ws, size_t ws_size, hipStream_t stream) {
    static int grid = 0;
    if (grid == 0) {
        if (n_in != 27 || out_size != MTOT * DM || ws_size < WS_END) { fprintf(stderr, "kernel_launch: unexpected problem (n_in %d, out %d, ws %zu, need %zu); nothing launched\n", n_in, out_size, ws_size, (size_t)WS_END); grid = -1; return; }
        int dev = 0, cus = 0, per_cu = 0;
        if (hipGetDevice(&dev) != hipSuccess || hipDeviceGetAttribute(&cus, hipDeviceAttributeMultiprocessorCount, dev) != hipSuccess) { grid = -1; return; }
        if (hipFuncSetAttribute((const void*)trunk_fwd, hipFuncAttributeMaxDynamicSharedMemorySize, LDS_BYTES) != hipSuccess) { fprintf(stderr, "kernel_launch: hipFuncSetAttribute failed\n"); grid = -1; return; }
        if (hipOccupancyMaxActiveBlocksPerMultiprocessor(&per_cu, (const void*)trunk_fwd, NTHREADS, LDS_BYTES) != hipSuccess || per_cu < 1) { fprintf(stderr, "kernel_launch: occupancy query reports %d\n", per_cu); }
        (void)hipGetLastError();
        grid = cus;
    }
    if (grid < 0) return;
    (void)in_sizes;
    if (hipMemsetAsync((char*)d_ws + WS_CTL, 0, CTL_ZERO_BYTES, stream) != hipSuccess) return;
    Params p{};
    for (int i = 0; i < 27; ++i) p.in[i] = (const float*)d_in[i];
    p.out = (float*)d_out; p.ws = (unsigned char*)d_ws;
    hipLaunchKernelGGL(trunk_fwd, dim3(grid), dim3(NTHREADS), LDS_BYTES, stream, p);
}
```

```cpp
#include <hip/hip_runtime.h>
#include <cstdio>
#include <cstdint>

#define DI __device__ __forceinline__
#define LAS __attribute__((address_space(3)))
#define GAS __attribute__((address_space(1)))

typedef unsigned short bf16_t;
typedef short bf16x8 __attribute__((ext_vector_type(8)));
typedef short s16x4 __attribute__((ext_vector_type(4)));
typedef float f32x4 __attribute__((ext_vector_type(4)));
typedef float f32x2 __attribute__((ext_vector_type(2)));
typedef float f32x16 __attribute__((ext_vector_type(16)));
typedef unsigned u32x4 __attribute__((ext_vector_type(4)));
typedef unsigned u32x2 __attribute__((ext_vector_type(2)));

typedef GAS float gf32; typedef GAS bf16_t gbf16; typedef GAS unsigned char gu8; typedef GAS f32x4 gf32x4; typedef GAS f32x2 gf32x2; typedef GAS u32x4 gu32x4; typedef GAS u32x2 gu32x2; typedef GAS bf16x8 gbf16x8;

constexpr int DM = 2048, DFF = 5632, DEPTH = 2;
constexpr int M_PROMPT = 8 * 2048, M_SAMPLE = 8 * 4096, MTOT = M_PROMPT + M_SAMPLE;
constexpr int NCHUNK = 2;
constexpr int MCMAX = 32768;
constexpr int N_IN = 15136;
constexpr int NPROJ = 7168, NGATE = 8192, NIN_PAD = NPROJ + NGATE;
constexpr int PC_AQ = 0, PC_AK = 1536, PC_AV = 3072, PC_CQ = 4608, PC_CKV = 4992, PC_KR = 5120, PC_C = 5376, PC_XR = 6144, PC_GT = 6656;
constexpr float EPS = 1e-6f;
constexpr float LOG2E = 1.4426950408889634f, LN2 = 0.6931471805599453f;

constexpr size_t MiB = 1u << 20;
constexpr size_t WS_CTL = 0, CTL_ZERO_BYTES = 1 * MiB;
constexpr size_t WS_ROPE = 1 * MiB;
constexpr size_t WS_SS = 2 * MiB;
constexpr size_t WS_WUP = 8 * MiB;
constexpr size_t WS_WDN = WS_WUP + 88 * MiB;
constexpr size_t WS_WIN = WS_WDN + 44 * MiB;
constexpr size_t WS_WBR = WS_WIN + 60 * MiB;
constexpr size_t WS_WOUT = WS_WBR + 8 * MiB;
constexpr size_t WS_WUQ = WS_WOUT + 8 * MiB;
constexpr size_t WS_WUKV = WS_WUQ + 1 * MiB;
constexpr size_t WS_WLRU = WS_WUKV + 1 * MiB;
constexpr size_t WS_XB = 220 * MiB;
constexpr size_t WS_BIG = 412 * MiB;
constexpr size_t WS_PROJ = WS_BIG;
constexpr size_t WS_MG = WS_PROJ;
constexpr size_t WS_G = WS_PROJ + 448 * MiB;
constexpr size_t WS_KVB = WS_G + 256 * MiB;
constexpr size_t WS_QR = WS_KVB + 64 * MiB;
constexpr size_t WS_LSE = WS_QR + 16 * MiB;
constexpr size_t WS_QSS = WS_LSE + 3 * MiB;
constexpr size_t WS_KSS = WS_QSS + 1 * MiB;
constexpr size_t WS_SUMF = WS_KSS + 1 * MiB;
constexpr size_t WS_SUMB = WS_SUMF + 4 * MiB;
constexpr size_t WS_CSF = WS_SUMB + 4 * MiB;
constexpr size_t WS_CSB = WS_CSF + 1 * MiB;
constexpr size_t WS_MIX_END = WS_CSB + 1 * MiB;
constexpr size_t WS_END = WS_MIX_END;
static_assert(WS_WLRU + 1 * MiB <= WS_XB && WS_XB + 192 * MiB <= WS_BIG && WS_BIG + 528 * MiB <= WS_MIX_END && WS_END <= 1216 * MiB, "d_ws map");
constexpr size_t OUT_Y = 0;
constexpr size_t OUT_XC = OUT_Y;
constexpr size_t OUT_AU = OUT_Y + 128 * MiB;
constexpr size_t OUT_OA = OUT_AU + 128 * MiB;
constexpr size_t OUT_QN = OUT_OA + 96 * MiB;
static_assert(OUT_QN + 32 * MiB <= (size_t)MTOT * DM * 4, "d_out scratch map");

constexpr int CW_BAR = 4096;

constexpr int RING_BYTES = 131072;
constexpr int LDSCTL_OFF = RING_BYTES, MISC_OFF = LDSCTL_OFF + 320;
constexpr int LDS_BYTES = 147456;
constexpr int NWAVES = 8, NTHREADS = 512;

typedef __attribute__((address_space(4))) const unsigned long long kargp_t;
DI unsigned long long ldk(int i) { kargp_t* ka = (kargp_t*)__builtin_amdgcn_kernarg_segment_ptr(); asm volatile("" : "+s"(ka)); return ka[i]; }
DI const gf32* kin(int i) { return (const gf32*)ldk(i); }
DI gf32* kout() { return (gf32*)ldk(27); }
DI gu8* kws() { return (gu8*)ldk(28); }
DI int ltid() { int t = threadIdx.x; asm volatile("" : "+v"(t)); return t; }
DI int lgrid() { int g = gridDim.x; asm volatile("" : "+s"(g)); return g; }
DI int lbid() { int b = blockIdx.x; asm volatile("" : "+s"(b)); return b; }
DI float bf2f(unsigned short b) { return __uint_as_float((unsigned)b << 16); }
DI unsigned f2bf(float f) { unsigned u = __float_as_uint(f); return (u + 0x7fffu + ((u >> 16) & 1u)) >> 16; }
DI unsigned pk2(float lo, float hi) { return f2bf(lo) | (f2bf(hi) << 16); }
DI void unpack8(const u32x4 w, float (&f)[8]) {
    f[0] = __uint_as_float(w.x << 16); f[1] = __uint_as_float(w.x & 0xffff0000u); f[2] = __uint_as_float(w.y << 16); f[3] = __uint_as_float(w.y & 0xffff0000u);
    f[4] = __uint_as_float(w.z << 16); f[5] = __uint_as_float(w.z & 0xffff0000u); f[6] = __uint_as_float(w.w << 16); f[7] = __uint_as_float(w.w & 0xffff0000u);
}
DI void unpack8u(const u32x2 w, float (&f)[8]) {
    f[0] = (float)(w.x & 255u); f[1] = (float)((w.x >> 8) & 255u); f[2] = (float)((w.x >> 16) & 255u); f[3] = (float)(w.x >> 24);
    f[4] = (float)(w.y & 255u); f[5] = (float)((w.y >> 8) & 255u); f[6] = (float)((w.y >> 16) & 255u); f[7] = (float)(w.y >> 24);
}
#define QG(x) fmaxf(__builtin_rintf((x) * 255.f), 1.f)
DI u32x2 pack8gate(const float (&g)[8]) {
    u32x2 w; w.x = 0u; w.y = 0u;
    w.x = __builtin_amdgcn_cvt_pk_u8_f32(QG(g[0]), 0, w.x); w.x = __builtin_amdgcn_cvt_pk_u8_f32(QG(g[1]), 1, w.x);
    w.x = __builtin_amdgcn_cvt_pk_u8_f32(QG(g[2]), 2, w.x); w.x = __builtin_amdgcn_cvt_pk_u8_f32(QG(g[3]), 3, w.x);
    w.y = __builtin_amdgcn_cvt_pk_u8_f32(QG(g[4]), 0, w.y); w.y = __builtin_amdgcn_cvt_pk_u8_f32(QG(g[5]), 1, w.y);
    w.y = __builtin_amdgcn_cvt_pk_u8_f32(QG(g[6]), 2, w.y); w.y = __builtin_amdgcn_cvt_pk_u8_f32(QG(g[7]), 3, w.y);
    return w;
}
DI u32x4 pack8(const float (&o)[8]) { u32x4 w; w.x = pk2(o[0], o[1]); w.y = pk2(o[2], o[3]); w.z = pk2(o[4], o[5]); w.w = pk2(o[6], o[7]); return w; }
DI float sigmoidf_(float x) { return __builtin_amdgcn_rcpf(1.f + __builtin_amdgcn_exp2f(x * -LOG2E)); }
DI float wave_sum(float v) {
#pragma unroll
    for (int o = 1; o < 64; o <<= 1) v += __shfl_xor(v, o);
    return v;
}

namespace pg8 {
constexpr int BM = 256, BK = 64, HALF = 128, HTB = HALF * BK * 2, STAGE_BYTES = 8 * HTB, NXCD = 8, WGM = 4;
__host__ __device__ __forceinline__ int lds_byte(int r, int c) { const int st = (r >> 4) * 2 + (c >> 5), rr = r & 15, cc = c & 31, ob = rr * 64 + cc * 2; return st * 1024 + (ob ^ (((ob >> 9) & 1) << 5)); }
__host__ __device__ __forceinline__ void stage_rc(int b, int& R, int& C) { const int st = b / 1024, sb = b % 1024, swz = sb ^ (((sb >> 9) & 1) << 5); R = (st >> 1) * 16 + swz / 64; C = (st & 1) * 32 + (swz % 64) / 2; }
__host__ __device__ __forceinline__ int perm32(int rho) { const int n = rho >> 4, i = rho & 15; return 8 * (i >> 2) + 4 * n + (i & 3); }

DI void glds16s(unsigned voff, const void* sbase, unsigned lds_dst) { unsigned keep;
    asm volatile("s_mov_b32 %0, m0\n\ts_mov_b32 m0, %3\n\ts_nop 0\n\tglobal_load_lds_dwordx4 %1, %2\n\ts_mov_b32 m0, %0" : "=&s"(keep) : "v"(voff), "s"(sbase), "s"(lds_dst) : "memory"); }
struct Unit { int pm, pn; };
struct Gemm { const gbf16* A; const gbf16* Bt; int M, N, K, lda, ldb, apn_shift, apn_stride, atile; };

struct StaticOrder {
    int nM, nN, nwg, G, c, pn0, skip_from, skip_by, wgm;
    DI void init(int M, int N, int G_, int c_, int pn0_ = 0, int skip_from_ = 1 << 30, int skip_by_ = 0, int wgm_ = WGM) { nM = M / BM; nN = N / BM; nwg = nM * nN; G = G_; c = c_; pn0 = pn0_; skip_from = skip_from_; skip_by = skip_by_; wgm = wgm_; }
    DI bool next(int i, Unit& u) const {
        const long L = (long)i * G + c; if (L >= nwg) return false;
        int wgid = (int)L; { const int q = nwg / NXCD, r = nwg % NXCD, xcd = wgid % NXCD, off = wgid / NXCD; wgid = (xcd < r ? xcd * (q + 1) : r * (q + 1) + (xcd - r) * q) + off; }
        const int nig = wgm * nN, gid = wgid / nig, fm = gid * wgm, gsz = (nM - fm) < wgm ? (nM - fm) : wgm;
        u.pm = fm + ((wgid % nig) % gsz); int pn = pn0 + (wgid % nig) / gsz; if (pn >= skip_from) pn += skip_by; u.pn = pn; return true;
    }
};

template <class Epi, bool ALIGN_EPI>
DI void gemm_phase(LAS unsigned char* lds, const Gemm g, const StaticOrder& S, const Epi& E, int stagger = 0) {
    if (stagger > 0) { const unsigned long long t0 = __builtin_amdgcn_s_memrealtime(); const unsigned long long d = (unsigned long long)(((lbid() >> 3) & 3) * stagger);
        while (__builtin_amdgcn_s_memrealtime() - t0 < d) __builtin_amdgcn_s_sleep(8); }
    const int tid = ltid(), wid = __builtin_amdgcn_readfirstlane(tid >> 6), lane = tid & 63, wr = wid >> 2, wc = wid & 3, fr = lane & 15, fq = lane >> 4;
    const int nt = g.K / BK;
    unsigned voffA[2], voffB[2];
#pragma unroll
    for (int i = 0; i < 2; ++i) { int R, C; stage_rc(tid * 16 + i * 8192, R, C); const int Rb = Epi::PERM ? ((R & ~31) + perm32(R & 31)) : R;
        voffA[i] = (unsigned)(R * g.lda + C) * 2u; voffB[i] = (unsigned)(Rb * g.ldb + C) * 2u; }
    const size_t kstep = (size_t)(BK * 2), kstepA = g.atile ? (size_t)(BM * BK * 2) : kstep;
    const size_t hstepA = (size_t)HALF * g.lda * 2, hstepB = (size_t)HALF * g.ldb * 2;
    const size_t tstepA = g.atile ? (size_t)BM * g.K * 2 : 2 * hstepA, tstepB = 2 * hstepB;
    const unsigned ldsw = (unsigned)wid * 1024u, lds32 = (unsigned)(uintptr_t)lds;
    const int aoff = lds_byte(wr * 64 + fr, fq * 8), boff = lds_byte(wc * 32 + fr, fq * 8);
#define PG8_UA(u) ((const char*)g.A + (size_t)(u).pm * tstepA + (size_t)(((u).pn >> g.apn_shift) * g.apn_stride) * 2)
#define PG8_UB(u) ((const char*)g.Bt + (size_t)(u).pn * tstepB)
#define PG8_SA(b, h) (((b) * 2 + (h)) * HTB)
#define PG8_SB(b, h) ((4 + (b) * 2 + (h)) * HTB)
#define PG8_STAGE(bufoff, gbase, voff) do { _Pragma("unroll") for (int _i = 0; _i < 2; ++_i) \
        glds16s((voff)[_i], (const void*)(gbase), lds32 + (unsigned)(bufoff) + ldsw + (unsigned)_i * 8192u); } while (0)
#define PG8_LDA(dst, b, h) do { _Pragma("unroll") for (int m = 0; m < 4; ++m) _Pragma("unroll") for (int k = 0; k < 2; ++k) dst[m][k] = *(const LAS bf16x8*)(lds + PG8_SA(b, h) + aoff + m * 2048 + k * 1024); } while (0)
#define PG8_LDB(dst, b, h) do { _Pragma("unroll") for (int n = 0; n < 2; ++n) _Pragma("unroll") for (int k = 0; k < 2; ++k) dst[n][k] = *(const LAS bf16x8*)(lds + PG8_SB(b, h) + boff + n * 2048 + k * 1024); } while (0)
#define PG8_MMA(ai, bj, At, Bt) do { __builtin_amdgcn_s_setprio(1); _Pragma("unroll") for (int m = 0; m < 4; ++m) _Pragma("unroll") for (int n = 0; n < 2; ++n) _Pragma("unroll") for (int k = 0; k < 2; ++k) \
        acc[ai][bj][m][n] = __builtin_amdgcn_mfma_f32_16x16x32_bf16(Bt[n][k], At[m][k], acc[ai][bj][m][n], 0, 0, 0); __builtin_amdgcn_s_setprio(0); } while (0)
#define PG8_WAIT_V(n) asm volatile("s_waitcnt vmcnt(" #n ")" ::: "memory")
#define PG8_WAIT_L(n) asm volatile("s_waitcnt lgkmcnt(" #n ")" ::: "memory")
#define PG8_BAR __builtin_amdgcn_s_barrier()
#define PG8_SCHED __builtin_amdgcn_sched_barrier(0)
    Unit cur, nxt; int ui = 0;
    if (!S.next(0, cur)) return;
    f32x4 acc[2][2][4][2];
#pragma unroll
    for (int a = 0; a < 2; ++a)
#pragma unroll
        for (int b = 0; b < 2; ++b)
#pragma unroll
            for (int m = 0; m < 4; ++m)
#pragma unroll
                for (int n = 0; n < 2; ++n) acc[a][b][m][n] = (f32x4){0.f, 0.f, 0.f, 0.f};
    bf16x8 At[4][2], B0[2][2], B1[2][2];
    const char* cA = PG8_UA(cur); const char* cB = PG8_UB(cur);
    PG8_STAGE(PG8_SB(0, 0), cB, voffB); PG8_STAGE(PG8_SB(0, 1), cB + hstepB, voffB); PG8_STAGE(PG8_SA(0, 0), cA, voffA); PG8_STAGE(PG8_SA(0, 1), cA + hstepA, voffA);
    if (wr == 1) PG8_BAR;
    PG8_WAIT_V(2); PG8_BAR;
    PG8_STAGE(PG8_SB(1, 0), cB + kstep, voffB); PG8_STAGE(PG8_SA(1, 0), cA + kstepA, voffA); PG8_STAGE(PG8_SB(1, 1), cB + hstepB + kstep, voffB);
    PG8_WAIT_V(6); PG8_BAR;
    for (;;) {
        const bool has_next = S.next(ui + 1, nxt);
        const char* nA = has_next ? PG8_UA(nxt) : cA; const char* nB = has_next ? PG8_UB(nxt) : cB;
        for (int t = 0; t < nt; t += 2) {
            const bool last = (t == nt - 2);
            const char* a1 = cA + (size_t)(t + 1) * kstepA;
            const char* a2 = last ? nA : cA + (size_t)(t + 2) * kstepA; const char* b2 = last ? nB : cB + (size_t)(t + 2) * kstep;
            const char* a3 = a2 + kstepA; const char* b3 = b2 + kstep;
            PG8_LDB(B0, 0, 0); PG8_LDB(B1, 0, 1); PG8_SCHED; PG8_LDA(At, 0, 0); PG8_STAGE(PG8_SA(1, 1), a1 + hstepA, voffA);
            PG8_WAIT_V(8); PG8_WAIT_L(0); PG8_BAR; PG8_MMA(0, 0, At, B0); PG8_MMA(0, 1, At, B1); PG8_BAR; PG8_SCHED;
            PG8_LDA(At, 0, 1); PG8_STAGE(PG8_SB(0, 0), b2, voffB); PG8_STAGE(PG8_SB(0, 1), b2 + hstepB, voffB); PG8_STAGE(PG8_SA(0, 0), a2, voffA);
            PG8_WAIT_V(8); PG8_WAIT_L(0); PG8_BAR; PG8_MMA(1, 0, At, B0); PG8_MMA(1, 1, At, B1); PG8_BAR; PG8_SCHED;
            PG8_LDB(B0, 1, 0); PG8_LDB(B1, 1, 1); PG8_SCHED; PG8_LDA(At, 1, 0); PG8_STAGE(PG8_SA(0, 1), a2 + hstepA, voffA);
            PG8_WAIT_V(8); PG8_WAIT_L(0); PG8_BAR; PG8_MMA(0, 0, At, B0); PG8_MMA(0, 1, At, B1); PG8_BAR; PG8_SCHED;
            PG8_LDA(At, 1, 1); PG8_STAGE(PG8_SB(1, 0), b3, voffB); PG8_STAGE(PG8_SB(1, 1), b3 + hstepB, voffB); PG8_STAGE(PG8_SA(1, 0), a3, voffA);
            PG8_WAIT_V(8); PG8_WAIT_L(0); PG8_BAR; PG8_MMA(1, 0, At, B0); PG8_MMA(1, 1, At, B1); PG8_BAR; PG8_SCHED;
            if constexpr (Epi::MID) { if (!last && ((t + 2) & 7) == 0) E.mid(acc, cur, (t + 2) >> 3, wr, wc, fr, fq); }
        }
        if constexpr (ALIGN_EPI) { if (wr == 0) PG8_BAR; }
        E(acc, cur, wr, wc, fr, fq);
        if (!has_next) break;
#pragma unroll
        for (int a = 0; a < 2; ++a)
#pragma unroll
            for (int b = 0; b < 2; ++b)
#pragma unroll
                for (int m = 0; m < 4; ++m)
#pragma unroll
                    for (int n = 0; n < 2; ++n) acc[a][b][m][n] = (f32x4){0.f, 0.f, 0.f, 0.f};
        cur = nxt; cA = nA; cB = nB; ++ui;
        if constexpr (ALIGN_EPI) { if (wr == 1) PG8_BAR; }
    }
    PG8_WAIT_V(0);
    if constexpr (!ALIGN_EPI) { if (wr == 0) PG8_BAR; }
    PG8_BAR;
#undef PG8_UA
#undef PG8_UB
#undef PG8_SA
#undef PG8_SB
#undef PG8_STAGE
#undef PG8_LDA
#undef PG8_LDB
#undef PG8_MMA
#undef PG8_WAIT_V
#undef PG8_WAIT_L
#undef PG8_BAR
#undef PG8_SCHED
}
}

namespace epi {
using pg8::Unit;
typedef const f32x4 (&AccC)[2][2][4][2];
typedef f32x4 (&AccM)[2][2][4][2];

DI void row_rstd32(const gf32* SS, int rowb, int fq, float invn, float (&rs)[2][4]) {
#pragma unroll
    for (int ai = 0; ai < 2; ++ai)
#pragma unroll
        for (int m = 0; m < 4; ++m) {
            const gf32x4* p = (const gf32x4*)(SS + (size_t)(rowb + ai * 128 + m * 16) * 32) + fq * 2;
            const f32x4 a = p[0], b = p[1];
            float s = ((a.x + a.y) + (a.z + a.w)) + ((b.x + b.y) + (b.z + b.w));
            s += __shfl_xor(s, 16); s += __shfl_xor(s, 32);
            rs[ai][m] = rsqrtf(s * invn + EPS);
        }
}
constexpr int RSTD_CACHE_OFF = LDSCTL_OFF + 4096;
DI void row_rstd_cached(const gf32* SS, unsigned tag, int rowb, int fq, int fr, int wid, float (&rs)[2][4]) {
    LAS float* cache = (LAS float*)(uintptr_t)(RSTD_CACHE_OFF + wid * 1024);
    const unsigned have = __builtin_amdgcn_readfirstlane(((LAS unsigned*)cache)[255]);
    if (have != tag) {
        row_rstd32(SS, rowb, fq, 1.f / (float)DM, rs);
        if (fq == 0) {
#pragma unroll
            for (int ai = 0; ai < 2; ++ai)
#pragma unroll
                for (int m = 0; m < 4; ++m) cache[(ai * 4 + m) * 16 + fr] = rs[ai][m];
        }
        ((LAS unsigned*)cache)[255] = tag;
    } else {
#pragma unroll
        for (int ai = 0; ai < 2; ++ai)
#pragma unroll
            for (int m = 0; m < 4; ++m) rs[ai][m] = cache[(ai * 4 + m) * 16 + fr];
    }
}
DI size_t gate_off(int pm, int t, int wid, int slot, int lane) { return ((((size_t)(pm * 32 + t) * 8 + wid) * 16 + slot) * 64 + lane) * 8; }
DI void rope8(float (&o)[8], const gf32* tab, int fq) {
    const f32x4 c0 = *(const gf32x4*)(tab + fq * 8), c1 = *(const gf32x4*)(tab + fq * 8 + 4);
    float a, b;
    a = o[0]; b = o[1]; o[0] = a * c0.x - b * c0.y; o[1] = a * c0.y + b * c0.x;
    a = o[2]; b = o[3]; o[2] = a * c0.z - b * c0.w; o[3] = a * c0.w + b * c0.z;
    a = o[4]; b = o[5]; o[4] = a * c1.x - b * c1.y; o[5] = a * c1.y + b * c1.x;
    a = o[6]; b = o[7]; o[6] = a * c1.z - b * c1.w; o[7] = a * c1.w + b * c1.z;
}

struct EpiSwiGLU {
    static constexpr bool PERM = true, MID = false;
    unsigned uid;
    DI void operator()(AccC acc, const Unit& u, int wr, int wc, int fr, int fq) const {
        gu8* ws = kws(); gbf16* U = (gbf16*)(ws + WS_BIG); const gf32* SS = (const gf32*)(ws + WS_SS);
        const int rowb = u.pm * 256 + wr * 64 + fr; float rs[2][4]; row_rstd_cached(SS, (uid << 16) | (unsigned)(u.pm + 1), rowb, fq, fr, wr * 4 + wc, rs);
        const size_t ubase = ((size_t)(u.pm * (DFF / 64) + 2 * u.pn + (wc >> 1)) * 256 + (wr * 64 + fr)) * 64 + (wc & 1) * 32 + 8 * fq;
#pragma unroll
        for (int ai = 0; ai < 2; ++ai)
#pragma unroll
            for (int m = 0; m < 4; ++m) { const float r = rs[ai][m], r2 = r * r, rl = r * -LOG2E; float o[8];
#pragma unroll
                for (int n = 0; n < 2; ++n)
#pragma unroll
                    for (int e = 0; e < 4; ++e) { const float a = acc[ai][0][m][n][e], b = acc[ai][1][m][n][e]; o[4 * n + e] = (a * b) * r2 * __builtin_amdgcn_rcpf(1.f + __builtin_amdgcn_exp2f(a * rl)); }
                __builtin_nontemporal_store(pack8(o), (gu32x4*)(U + ubase + (size_t)(ai * 128 + m * 16) * 64)); }
    }
};

struct EpiResidual {
    static constexpr bool PERM = true, MID = false;
    int row0; float s;
    DI void operator()(AccC acc, const Unit& u, int wr, int wc, int fr, int fq) const {
        gu8* ws = kws(); gbf16* XB = (gbf16*)(ws + WS_XB); gf32* SS = (gf32*)(ws + WS_SS);
        const int rowb = row0 + u.pm * 256 + wr * 64 + fr, col = u.pn * 256 + wc * 32 + 8 * fq;
#pragma unroll
        for (int ai = 0; ai < 2; ++ai) {
            u32x4 xv[4][2];
#pragma unroll
            for (int m = 0; m < 4; ++m)
#pragma unroll
                for (int bj = 0; bj < 2; ++bj) xv[m][bj] = *(const gu32x4*)(XB + (size_t)(rowb + ai * 128 + m * 16) * DM + col + bj * 128);
#pragma unroll
            for (int m = 0; m < 4; ++m) { const int row = rowb + ai * 128 + m * 16; float ss = 0.f;
#pragma unroll
                for (int bj = 0; bj < 2; ++bj) { float x[8]; unpack8(xv[m][bj], x);
#pragma unroll
                    for (int n = 0; n < 2; ++n)
#pragma unroll
                        for (int e = 0; e < 4; ++e) x[4 * n + e] += acc[ai][bj][m][n][e] * s;
                    const u32x4 w = pack8(x); *(gu32x4*)(XB + (size_t)row * DM + col + bj * 128) = w;
                    float xr[8]; unpack8(w, xr);
#pragma unroll
                    for (int e = 0; e < 8; ++e) ss += xr[e] * xr[e]; }
                ss += __shfl_xor(ss, 16); ss += __shfl_xor(ss, 32);
                if (fq == 0) SS[(size_t)row * 32 + u.pn * 4 + wc] = ss; }
            asm volatile("" ::: "memory");
        }
    }
};

struct EpiProj {
    static constexpr bool PERM = true, MID = false;
    int row0; int Lmask; unsigned uid;
    DI void operator()(AccC acc, const Unit& u, int wr, int wc, int fr, int fq) const {
        gu8* ws = kws();
        const int rowb = u.pm * 256 + wr * 64 + fr; float rs[2][4]; row_rstd_cached((const gf32*)(ws + WS_SS) + (size_t)row0 * 32, (uid << 16) | (unsigned)(u.pm + 1), rowb, fq, fr, wr * 4 + wc, rs);
        const int pn = u.pn, colin = wc * 32 + 8 * fq;
        if (pn >= 28) {
            gu8* G = ws + WS_G;
#pragma unroll
            for (int ai = 0; ai < 2; ++ai)
#pragma unroll
                for (int m = 0; m < 4; ++m) { const float rl = rs[ai][m] * -LOG2E;
#pragma unroll
                    for (int bj = 0; bj < 2; ++bj) { float o[8];
#pragma unroll
                        for (int n = 0; n < 2; ++n)
#pragma unroll
                            for (int e = 0; e < 4; ++e) o[4 * n + e] = __builtin_amdgcn_rcpf(1.f + __builtin_amdgcn_exp2f(acc[ai][bj][m][n][e] * rl));
                        *(gu32x2*)(G + gate_off(u.pm, pn - 28, wr * 4 + wc, (ai * 4 + m) * 2 + bj, fq * 16 + fr)) = pack8gate(o); } }
        } else {
            gbf16* PROJ = (gbf16*)(ws + WS_PROJ); gf32* QSS = (gf32*)(ws + WS_QSS); gf32* KSS = (gf32*)(ws + WS_KSS); const gf32* ROPE = (const gf32*)(ws + WS_ROPE);
            const float sc = (pn < 6 || pn == 21 || pn == 22) ? 0.125f * LOG2E : 1.f;
#pragma unroll
            for (int ai = 0; ai < 2; ++ai)
#pragma unroll
                for (int m = 0; m < 4; ++m) { const int row = rowb + ai * 128 + m * 16; const float r = rs[ai][m] * sc; float sq[2];
#pragma unroll
                    for (int bj = 0; bj < 2; ++bj) { float o[8]; float q = 0.f;
#pragma unroll
                        for (int n = 0; n < 2; ++n)
#pragma unroll
                            for (int e = 0; e < 4; ++e) { const float v = acc[ai][bj][m][n][e] * r; o[4 * n + e] = v; q += v * v; }
                        sq[bj] = q;
                        if (pn == 20 && bj == 0 && wc == 0) rope8(o, ROPE + (size_t)(row & Lmask) * 32, fq);
                        *(gu32x4*)(PROJ + (size_t)row * NPROJ + pn * 256 + bj * 128 + colin) = pack8(o); }
                    if (pn == 18 || pn == 19) {
                        float a = sq[0], b = sq[1];
                        a += __shfl_xor(a, 16); a += __shfl_xor(a, 32); b += __shfl_xor(b, 16); b += __shfl_xor(b, 32);
                        if (fq == 0) { if (pn == 18) QSS[(size_t)row * 8 + wc] = a + b; else { QSS[(size_t)row * 8 + 4 + wc] = a; KSS[(size_t)row * 4 + wc] = b; } }
                    } }
        }
    }
};

struct EpiMlaQ {
    static constexpr bool PERM = true, MID = false;
    int Lmask;
    DI void operator()(AccC acc, const Unit& u, int wr, int wc, int fr, int fq) const {
        gu8* ws = kws(); gbf16* QN = (gbf16*)((gu8*)kout() + OUT_QN); gbf16* QR = (gbf16*)(ws + WS_QR); const gf32* QSS = (const gf32*)(ws + WS_QSS); const gf32* ROPE = (const gf32*)(ws + WS_ROPE);
        const float scale = 0.10206207261596577f * LOG2E;
        const int rowb = u.pm * 256 + wr * 64 + fr, colin = u.pn * 256 + wc * 32 + 8 * fq;
#pragma unroll
        for (int ai = 0; ai < 2; ++ai)
#pragma unroll
            for (int m = 0; m < 4; ++m) { const int row = rowb + ai * 128 + m * 16;
                const f32x4 a = *(const gf32x4*)(QSS + (size_t)row * 8), b = *(const gf32x4*)(QSS + (size_t)row * 8 + 4);
                const float r = rsqrtf((((a.x + a.y) + (a.z + a.w)) + ((b.x + b.y) + (b.z + b.w))) * (1.f / 384.f) + EPS) * scale;
#pragma unroll
                for (int bj = 0; bj < 2; ++bj) { float o[8];
#pragma unroll
                    for (int n = 0; n < 2; ++n)
#pragma unroll
                        for (int e = 0; e < 4; ++e) o[4 * n + e] = acc[ai][bj][m][n][e] * r;
                    if (u.pn == 2) { rope8(o, ROPE + (size_t)(row & Lmask) * 32, fq); *(gu32x4*)(QR + (size_t)row * 256 + wc * 32 + 8 * fq + bj * 128) = pack8(o); }
                    else *(gu32x4*)(QN + (size_t)row * 512 + colin + bj * 128) = pack8(o); } }
    }
};
struct EpiMlaKV {
    static constexpr bool PERM = true, MID = false;
    DI void operator()(AccC acc, const Unit& u, int wr, int wc, int fr, int fq) const {
        gu8* ws = kws(); gbf16* KVB = (gbf16*)(ws + WS_KVB); const gf32* KSS = (const gf32*)(ws + WS_KSS);
        const int rowb = u.pm * 256 + wr * 64 + fr, colin = u.pn * 256 + wc * 32 + 8 * fq;
#pragma unroll
        for (int ai = 0; ai < 2; ++ai)
#pragma unroll
            for (int m = 0; m < 4; ++m) { const int row = rowb + ai * 128 + m * 16;
                const f32x4 a = *(const gf32x4*)(KSS + (size_t)row * 4);
                const float r = rsqrtf(((a.x + a.y) + (a.z + a.w)) * (1.f / 128.f) + EPS);
#pragma unroll
                for (int bj = 0; bj < 2; ++bj) { float o[8];
#pragma unroll
                    for (int n = 0; n < 2; ++n)
#pragma unroll
                        for (int e = 0; e < 4; ++e) o[4 * n + e] = acc[ai][bj][m][n][e] * r;
                    *(gu32x4*)(KVB + (size_t)row * 1024 + colin + bj * 128) = pack8(o); } }
    }
};
struct EpiLru {
    static constexpr bool PERM = true, MID = false;
    int layer;
    DI void operator()(AccC acc, const Unit& u, int wr, int wc, int fr, int fq) const {
        gu8* ws = kws(); GAS unsigned* AU = (GAS unsigned*)((gu8*)kout() + OUT_AU); const gbf16* XC = (const gbf16*)((gu8*)kout() + OUT_XC);
        const gf32* b_a = kin(15) + layer * 1024; const gf32* b_x = kin(17) + layer * 1024; const gf32* lam = kin(18) + layer * 1024;
        const int rowb = u.pm * 256 + wr * 64 + fr, ch0 = u.pn * 64 + wc * 16 + 4 * fq;
        u32x2 xwv[2][4];
#pragma unroll
        for (int ai = 0; ai < 2; ++ai)
#pragma unroll
            for (int m = 0; m < 4; ++m) xwv[ai][m] = *(const gu32x2*)(XC + (size_t)(rowb + ai * 128 + m * 16) * 512 + ch0);
#pragma unroll
        for (int bj = 0; bj < 2; ++bj) {
            const f32x4 ba = *(const gf32x4*)(b_a + bj * 512 + ch0), bx = *(const gf32x4*)(b_x + bj * 512 + ch0), lm = *(const gf32x4*)(lam + bj * 512 + ch0);
            float sp[4];
#pragma unroll
            for (int e = 0; e < 4; ++e) sp[e] = (-8.f * LOG2E) * log1pf(__expf(-lm[e]));
#pragma unroll
            for (int ai = 0; ai < 2; ++ai)
#pragma unroll
                for (int m = 0; m < 4; ++m) { const int row = rowb + ai * 128 + m * 16;
                    const u32x2 xw = xwv[ai][m];
                    const float xc[4] = {__uint_as_float(xw.x << 16), __uint_as_float(xw.x & 0xffff0000u), __uint_as_float(xw.y << 16), __uint_as_float(xw.y & 0xffff0000u)};
                    float o[8];
#pragma unroll
                    for (int e = 0; e < 4; ++e) { const float pr = acc[ai][bj][m][e >> 1][(e & 1) * 2], pi = acc[ai][bj][m][e >> 1][(e & 1) * 2 + 1];
                        const float r = sigmoidf_(pr + ba[e]), ig = sigmoidf_(pi + bx[e]);
                        const float a1 = __builtin_amdgcn_exp2f(r * sp[e]); o[2 * e] = 1.f - a1; o[2 * e + 1] = __builtin_amdgcn_sqrtf(fmaxf(1.f - a1 * a1, 0.f)) * (ig * xc[e]); }
                    u32x4 w; w.x = pk2(o[0], o[1]); w.y = pk2(o[2], o[3]); w.z = pk2(o[4], o[5]); w.w = pk2(o[6], o[7]);
                    *(gu32x4*)(AU + (size_t)(row * 2 + bj) * 512 + ch0) = w;
                    asm volatile("" ::: "memory"); }
        }
    }
};
struct EpiBranch {
    static constexpr bool PERM = true, MID = true;
    DI void mid(AccM acc, const Unit& u, int b, int wr, int wc, int fr, int fq) const {
        const gu8* G = kws() + WS_G;
        const int rowb = u.pm * 256 + wr * 64 + fr, col = u.pn * 256 + wc * 32 + 8 * fq;
#pragma unroll
        for (int ai = 0; ai < 2; ++ai) {
            u32x2 w0[4][2], w1[4][2];
#pragma unroll
            for (int m = 0; m < 4; ++m)
#pragma unroll
                for (int bj = 0; bj < 2; ++bj) { const int slot = (ai * 4 + m) * 2 + bj, wid = wr * 4 + wc, ln = fq * 16 + fr;
                    w0[m][bj] = *(const gu32x2*)(G + gate_off(u.pm, 8 * (b - 1) + u.pn, wid, slot, ln)); w1[m][bj] = *(const gu32x2*)(G + gate_off(u.pm, 8 * b + u.pn, wid, slot, ln)); }
#pragma unroll
            for (int m = 0; m < 4; ++m)
#pragma unroll
                for (int bj = 0; bj < 2; ++bj) { float g0[8], g1[8]; unpack8u(w0[m][bj], g0); unpack8u(w1[m][bj], g1);
#pragma unroll
                    for (int n = 0; n < 2; ++n)
#pragma unroll
                        for (int e = 0; e < 4; ++e) acc[ai][bj][m][n][e] *= g0[4 * n + e] * __builtin_amdgcn_rcpf(g1[4 * n + e]); }
        }
    }
    DI void operator()(AccC acc, const Unit& u, int wr, int wc, int fr, int fq) const {
        gu8* ws = kws(); const gu8* G = ws + WS_G; gbf16* MG = (gbf16*)(ws + WS_MG);
        const int rowb = u.pm * 256 + wr * 64 + fr, col = u.pn * 256 + wc * 32 + 8 * fq;
#pragma unroll
        for (int ai = 0; ai < 2; ++ai) {
            u32x2 w3[4][2];
#pragma unroll
            for (int m = 0; m < 4; ++m)
#pragma unroll
                for (int bj = 0; bj < 2; ++bj) w3[m][bj] = *(const gu32x2*)(G + gate_off(u.pm, 24 + u.pn, wr * 4 + wc, (ai * 4 + m) * 2 + bj, fq * 16 + fr));
#pragma unroll
            for (int m = 0; m < 4; ++m) { const int row = rowb + ai * 128 + m * 16;
#pragma unroll
                for (int bj = 0; bj < 2; ++bj) { float g3[8]; unpack8u(w3[m][bj], g3); float o[8];
#pragma unroll
                    for (int n = 0; n < 2; ++n)
#pragma unroll
                        for (int e = 0; e < 4; ++e) o[4 * n + e] = acc[ai][bj][m][n][e] * (g3[4 * n + e] * (1.f / 255.f));
                    *(gu32x4*)(MG + (size_t)row * DM + col + bj * 128) = pack8(o); } }
        }
    }
};
}

namespace att {
typedef short v4i16_t __attribute__((ext_vector_type(4)));
constexpr int KSTR64 = 144, KSTR96 = 208, VSTR = 192;
DI int crow(int r, int h) { return (r & 3) + 8 * (r >> 2) + 4 * h; }
DI s16x4 vtr(const LAS unsigned char* p) { return __builtin_bit_cast(s16x4, __builtin_amdgcn_ds_read_tr16_b64_v4i16((LAS v4i16_t*)p)); }
DI unsigned cvtpk(float lo, float hi) { typedef __bf16 bf2 __attribute__((ext_vector_type(2))); f32x2 v = {lo, hi}; bf2 b = __builtin_convertvector(v, bf2); return __builtin_bit_cast(unsigned, b); }

struct NoMask { DI float operator()(float s, int) const { return s; } };
struct BandMask {
    int kq; float slope2; int R;
    DI float operator()(float s, int koff) const { const int rel = kq + koff; const int ar = rel < 0 ? -rel : rel; return ar <= R ? s - slope2 * (float)ar : -1e30f; }
};

DI float half_max(float v) { auto rr = __builtin_amdgcn_permlane32_swap(__float_as_uint(v), __float_as_uint(v), false, false); return fmaxf(__uint_as_float(rr[0]), __uint_as_float(rr[1])); }
DI float half_sum(float v) { auto rr = __builtin_amdgcn_permlane32_swap(__float_as_uint(v), __float_as_uint(v), false, false); return __uint_as_float(rr[0]) + __uint_as_float(rr[1]); }

template <int NKS, int KSTR>
DI void ld_k(bf16x8 (&kf)[NKS], const LAS unsigned char* kt, int lane) {
    const LAS unsigned char* kp = kt + (lane & 31) * KSTR + (lane >> 5) * 16;
#pragma unroll
    for (int ks = 0; ks < NKS; ++ks) kf[ks] = *(const LAS bf16x8*)(kp + ks * 32);
}
DI void ld_v(bf16x8 (&vf)[4], const LAS unsigned char* vt, int lane) {
    const int h = lane >> 5, i16 = lane & 15, q4 = i16 >> 2, p4 = i16 & 3, g1 = (lane >> 4) & 1;
    const LAS unsigned char* vp = vt + (4 * h + q4) * VSTR + g1 * 32 + p4 * 8;
#pragma unroll
    for (int db = 0; db < 2; ++db)
#pragma unroll
        for (int st = 0; st < 2; ++st) {
            const s16x4 lo = vtr(vp + (16 * st) * VSTR + db * 64), hi = vtr(vp + (16 * st + 8) * VSTR + db * 64);
            vf[2 * db + st] = (bf16x8){lo[0], lo[1], lo[2], lo[3], hi[0], hi[1], hi[2], hi[3]};
        }
}
template <int NKS>
DI void mm_qk(f32x16& s, const bf16x8 (&kf)[NKS], const bf16x8 (&qf)[NKS]) {
#pragma unroll
    for (int r = 0; r < 16; ++r) s[r] = 0.f;
#pragma unroll
    for (int ks = 0; ks < NKS; ++ks) s = __builtin_amdgcn_mfma_f32_32x32x16_bf16(kf[ks], qf[ks], s, 0, 0, 0);
}
template <int NKS>
DI void mm_qk_acc(f32x16& s, const bf16x8 (&kf)[NKS], const bf16x8 (&qf)[NKS]) {
#pragma unroll
    for (int ks = 0; ks < NKS; ++ks) s = __builtin_amdgcn_mfma_f32_32x32x16_bf16(kf[ks], qf[ks], s, 0, 0, 0);
}
template <int R>
DI void band_init(f32x16& s, int d, int r32, int h, float nslope2) {
    const float xb = (float)(d + 4 * h - r32);
    const bool partial = (d <= -R) || (d >= R);
#pragma unroll
    for (int r = 0; r < 16; ++r) { const float ax = __builtin_fabsf(xb + (float)((r & 3) + 8 * (r >> 2))); float b = nslope2 * ax; if (partial) b = ax <= (float)R ? b : -1e30f; s[r] = b; }
}
template <bool MASKED, class Mask>
DI void sm_max(f32x16& s, f32x16 (&o)[2], float& m, float& l, int lane, const Mask& mk) {
    const int h = lane >> 5;
    float tmax = -1e30f;
#pragma unroll
    for (int r = 0; r < 16; ++r) { if (MASKED) s[r] = mk(s[r], crow(r, h)); tmax = fmaxf(tmax, s[r]); }
    tmax = half_max(tmax);
    const float mnew = fmaxf(m, tmax);
    if (__any(mnew > m + 8.f)) { const float al = __builtin_amdgcn_exp2f(m - mnew); l *= al;
#pragma unroll
        for (int r = 0; r < 16; ++r) { o[0][r] *= al; o[1][r] *= al; }
        m = mnew; }
}
template <bool MASKED>
DI void sm_exp(const f32x16& s, float m, float& l, bf16x8 (&pf)[2]) {
    float p[16]; float ps = 0.f;
#pragma unroll
    for (int r = 0; r < 16; ++r) { const float e = __builtin_amdgcn_exp2f(s[r] - m); p[r] = (!MASKED || s[r] > -1e29f) ? e : 0.f; ps += p[r]; }
    l += ps;
#pragma unroll
    for (int st = 0; st < 2; ++st) { u32x4 w; w.x = cvtpk(p[8 * st], p[8 * st + 1]); w.y = cvtpk(p[8 * st + 2], p[8 * st + 3]); w.z = cvtpk(p[8 * st + 4], p[8 * st + 5]); w.w = cvtpk(p[8 * st + 6], p[8 * st + 7]);
        pf[st] = __builtin_bit_cast(bf16x8, w); }
}
template <int NKS> DI void hint_mfma_valu() {
#pragma unroll
    for (int i = 0; i < NKS; ++i) { __builtin_amdgcn_sched_group_barrier(0x008, 1, 0); __builtin_amdgcn_sched_group_barrier(0x002, 12, 0); }
}
DI void mm_pv(f32x16 (&o)[2], const bf16x8 (&vf)[4], const bf16x8 (&pf)[2]) {
#pragma unroll
    for (int db = 0; db < 2; ++db)
#pragma unroll
        for (int st = 0; st < 2; ++st) o[db] = __builtin_amdgcn_mfma_f32_32x32x16_bf16(vf[2 * db + st], pf[st], o[db], 0, 0, 0);
}
DI void store_o(const f32x16 (&o)[2], float inv, gbf16* Orow, int h) {
#pragma unroll
    for (int db = 0; db < 2; ++db)
#pragma unroll
        for (int g4 = 0; g4 < 4; ++g4) { u32x2 w; w.x = pk2(o[db][4 * g4] * inv, o[db][4 * g4 + 1] * inv); w.y = pk2(o[db][4 * g4 + 2] * inv, o[db][4 * g4 + 3] * inv);
            *(gu32x2*)(Orow + 32 * db + 8 * g4 + 4 * h) = w; }
}

template <int R, bool SINK>
DI void banded_unit(LAS unsigned char* lds, const gbf16* Kp, const gbf16* Vp, size_t rs, int w0, int w1, bool active, const gbf16* Qp, int qw, float slope2, float sink2,
                    gbf16* Op, size_t ors, gf32* Lp, size_t lrs) {
    constexpr int VOFF = 384 * KSTR64;
    const int tid = ltid(), lane = tid & 63, r32 = lane & 31, h = lane >> 5;
    const int nrow = w1 - w0;
    for (int idx = tid; idx < nrow * 8; idx += NTHREADS) { const int i = idx >> 3, c = idx & 7;
        const u32x4 kv = *(const gu32x4*)(Kp + (size_t)(w0 + i) * rs + c * 8); const u32x4 vv = *(const gu32x4*)(Vp + (size_t)(w0 + i) * rs + c * 8);
        *(LAS u32x4*)(lds + i * KSTR64 + c * 16) = kv; *(LAS u32x4*)(lds + VOFF + i * VSTR + c * 16) = vv; }
    __syncthreads();
    if (active) {
        bf16x8 qf[4];
        const gbf16* qrow = Qp + (size_t)(qw + r32) * rs;
#pragma unroll
        for (int ks = 0; ks < 4; ++ks) qf[ks] = *(const gbf16x8*)(qrow + 16 * ks + 8 * h);
        f32x16 o[2];
#pragma unroll
        for (int r = 0; r < 16; ++r) { o[0][r] = 0.f; o[1][r] = 0.f; }
        float m = -1e30f, l = 0.f;
        int k0 = qw - R; if (k0 < w0) k0 = w0; int k1 = qw + 32 + R; if (k1 > w1) k1 = w1;
        f32x16 sA, sB; bf16x8 kf[4], vf[4], pf[2];
        ld_k<4, KSTR64>(kf, lds + (k0 - w0) * KSTR64, lane); band_init<R>(sA, k0 - qw, r32, h, -slope2); mm_qk_acc<4>(sA, kf, qf);
        if (k0 + 32 < k1) ld_k<4, KSTR64>(kf, lds + (k0 + 32 - w0) * KSTR64, lane);
        for (int kt = k0; kt < k1; kt += 32) {
            ld_v(vf, lds + VOFF + (kt - w0) * VSTR, lane);
            sm_max<false, NoMask>(sA, o, m, l, lane, NoMask{});
            __builtin_amdgcn_sched_barrier(0);
            if (kt + 32 < k1) { band_init<R>(sB, kt + 32 - qw, r32, h, -slope2); mm_qk_acc<4>(sB, kf, qf); }
            sm_exp<false>(sA, m, l, pf);
            hint_mfma_valu<4>();
            __builtin_amdgcn_sched_barrier(0);
            if (kt + 64 < k1) ld_k<4, KSTR64>(kf, lds + (kt + 64 - w0) * KSTR64, lane);
            mm_pv(o, vf, pf);
            sA = sB;
        }
        l = half_sum(l);
        if (SINK) l += __builtin_amdgcn_exp2f(sink2 - m);
        const float inv = 1.f / l;
        store_o(o, inv, Op + (size_t)(qw + r32) * ors, h);
        if (Lp != nullptr && h == 0) Lp[(size_t)(qw + r32) * lrs] = (m + __builtin_amdgcn_logf(l)) * LN2;
    }
    __syncthreads();
}

template <bool FAST>
DI bool mla_unit(LAS unsigned char* lds, const gbf16* Kn, const gbf16* Kr, const gbf16* Vp, int L, const gbf16* Qn, const gbf16* Qr, gbf16* Op) {
    constexpr int BUF = 128 * KSTR96 + 128 * VSTR, VOFF = 128 * KSTR96;
    const int tid = ltid(), lane = tid & 63, r32 = lane & 31, h = lane >> 5, wid = tid >> 6;
    bf16x8 qf[6];
    { const gbf16* qn = Qn + (size_t)(wid * 32 + r32) * 512; const gbf16* qr = Qr + (size_t)(wid * 32 + r32) * 256;
#pragma unroll
      for (int ks = 0; ks < 4; ++ks) qf[ks] = *(const gbf16x8*)(qn + 16 * ks + 8 * h);
#pragma unroll
      for (int ks = 0; ks < 2; ++ks) qf[4 + ks] = *(const gbf16x8*)(qr + 16 * ks + 8 * h); }
    f32x16 o[2];
#pragma unroll
    for (int r = 0; r < 16; ++r) { o[0][r] = 0.f; o[1][r] = 0.f; }
    float m = -1e30f, l = 0.f;
    volatile LAS unsigned* flag = (volatile LAS unsigned*)(lds + MISC_OFF) + 20;
    if (FAST && tid == 0) flag[0] = 0u;
    u32x4 preA[5], preB[5];
    const int ns = L / 128;
#define MLA_LOAD(pre, st) do { const size_t k0_ = (size_t)(st) * 128; \
        _Pragma("unroll") for (int j = 0; j < 2; ++j) { const int idx = tid + NTHREADS * j; const size_t key = k0_ + (idx >> 3); pre[j] = *(const gu32x4*)(Kn + key * 1024 + (idx & 7) * 8); pre[3 + j] = *(const gu32x4*)(Vp + key * 1024 + (idx & 7) * 8); } \
        pre[2] = *(const gu32x4*)(Kr + (k0_ + (tid >> 2)) * NPROJ + (tid & 3) * 8); } while (0)
#define MLA_WRITE(pre, b) do { _Pragma("unroll") for (int j = 0; j < 2; ++j) { const int idx = tid + NTHREADS * j; \
            *(LAS u32x4*)(lds + (b) * BUF + (idx >> 3) * KSTR96 + (idx & 7) * 16) = pre[j]; *(LAS u32x4*)(lds + (b) * BUF + VOFF + (idx >> 3) * VSTR + (idx & 7) * 16) = pre[3 + j]; } \
        *(LAS u32x4*)(lds + (b) * BUF + (tid >> 2) * KSTR96 + 128 + (tid & 3) * 16) = pre[2]; } while (0)
#define MLA_STAGE(b) do { f32x16 sA, sB; bf16x8 kf[6], vf[4], pf[2];     \
          const LAS unsigned char* kb = lds + (b) * BUF; const LAS unsigned char* vb = lds + (b) * BUF + VOFF; \
          ld_k<6, KSTR96>(kf, kb, lane); mm_qk<6>(sA, kf, qf); ld_k<6, KSTR96>(kf, kb + 32 * KSTR96, lane); \
          _Pragma("unroll") for (int j = 0; j < 4; ++j) { \
              ld_v(vf, vb + j * 32 * VSTR, lane); \
              if (!FAST) sm_max<false, NoMask>(sA, o, m, l, lane, NoMask()); \
              else { float z_ = 0.f; asm volatile("" : "+v"(z_)); if (__any(z_ > 0.f)) { l *= 0.5f; _Pragma("unroll") for (int r_ = 0; r_ < 16; ++r_) { o[0][r_] *= 0.5f; o[1][r_] *= 0.5f; } } }     \
              __builtin_amdgcn_sched_barrier(0); \
              if (j < 3) mm_qk<6>(sB, kf, qf); \
              sm_exp<false>(sA, FAST ? 0.f : m, l, pf); \
              hint_mfma_valu<6>(); \
              __builtin_amdgcn_sched_barrier(0); \
              if (j < 2) ld_k<6, KSTR96>(kf, kb + (j + 2) * 32 * KSTR96, lane); \
              mm_pv(o, vf, pf); \
              if (j < 3) sA = sB; \
          } } while (0)
    MLA_LOAD(preA, 0); MLA_LOAD(preB, 1); MLA_WRITE(preA, 0);
    __syncthreads();
    for (int st = 0; st < ns; st += 2) {
        if (st + 2 < ns) MLA_LOAD(preA, st + 2);
        MLA_STAGE(0);
        MLA_WRITE(preB, 1);
        __syncthreads();
        if (st + 3 < ns) MLA_LOAD(preB, st + 3);
        MLA_STAGE(1);
        if (st + 2 < ns) MLA_WRITE(preA, 0);
        __syncthreads();
    }
#undef MLA_LOAD
#undef MLA_WRITE
#undef MLA_STAGE
    l = half_sum(l);
    store_o(o, 1.f / l, Op + (size_t)(wid * 32 + r32) * DM, h);
    if (!FAST) return true;
    if (!(l > 1e-30f && l < 1e30f)) flag[0] = 1u;
    __syncthreads();
    const bool ok = flag[0] == 0u;
    __syncthreads();
    return ok;
}
}

#define XB_TMO      128
#define XB_XCNT(j)  (256  + 64 * (j))
#define XB_XSUB(j)  (1280 + 64 * (j))
#define XB_XGEN(j)  (2304 + 64 * (j))
#define XB_TOP      3328
#define XB_TOPGEN   3392
#define XCD_BAR_WORDS 3456
#define XB_SPIN_CAP (1u << 20)

DI unsigned xb_ld(unsigned* p)              { return __hip_atomic_load(p, __ATOMIC_RELAXED, __HIP_MEMORY_SCOPE_AGENT); }
DI unsigned xb_add(unsigned* p, unsigned v) { return __hip_atomic_fetch_add(p, v, __ATOMIC_RELAXED, __HIP_MEMORY_SCOPE_AGENT); }
DI unsigned xb_xcc_id() { return (unsigned)__builtin_amdgcn_s_getreg((3 << 11) | 20) & 0xFu; }
#define XB_SPIN(cond, bar) do { unsigned _sp = 0; while (cond) { __builtin_amdgcn_s_sleep(1); \
    if ((++_sp & 255u) == 0u) { if (xb_ld(&(bar)[XB_TMO])) break; if (_sp > XB_SPIN_CAP) { atomicAdd(&(bar)[XB_TMO], 1u); break; } } } } while (0)

struct XcdBarrier { unsigned* bar; unsigned x; volatile LAS unsigned* st; };

DI XcdBarrier xcd_barrier_post(unsigned* bar, volatile LAS unsigned* st) {
    XcdBarrier b; b.bar = bar; b.x = xb_xcc_id(); b.st = st;
    if (threadIdx.x == 0) (void)xb_add(&bar[XB_XCNT(b.x)], 1u);
    return b;
}
DI void xcd_barrier_complete(unsigned* bar, unsigned x, unsigned& nloc, unsigned& nx) {
    const unsigned G = gridDim.x * gridDim.y * gridDim.z;
    unsigned sum, cnt, mine, sp = 0u;
    for (;;) {
        sum = 0u; cnt = 0u; mine = 0u;
#pragma unroll
        for (unsigned j = 0; j < 16; ++j) { const unsigned c = xb_ld(&bar[XB_XCNT(j)]); sum += c; cnt += (c > 0u) ? 1u : 0u; mine = (j == x) ? c : mine; }
        if (sum == G) break;
        __builtin_amdgcn_s_sleep(1);
        if ((++sp & 255u) == 0u) { if (xb_ld(&bar[XB_TMO])) break; if (sp > XB_SPIN_CAP) { atomicAdd(&bar[XB_TMO], 1u); break; } }
    }
    nloc = mine > 0u ? mine : 1u; nx = cnt > 0u ? cnt : 1u;
}
DI void xcd_barrier(const XcdBarrier& b) {
    asm volatile("s_waitcnt vmcnt(0)" ::: "memory");
    __syncthreads();
    if (threadIdx.x == 0) {
        unsigned* bar = b.bar;
        __builtin_amdgcn_s_waitcnt(0);
        unsigned nloc = b.st[0], nx = b.st[1];
        if (nloc == 0u) { xcd_barrier_complete(bar, b.x, nloc, nx); b.st[0] = nloc; b.st[1] = nx; }
        const unsigned old = xb_add(&bar[XB_XSUB(b.x)], 1u);
        const unsigned gen = old / nloc;
        if (old + 1u == (gen + 1u) * nloc) {
            __builtin_amdgcn_fence(__ATOMIC_RELEASE, "agent");
            asm volatile("s_waitcnt vmcnt(0)" ::: "memory");
            const unsigned og = xb_add(&bar[XB_TOP], 1u);
            const unsigned tg = og / nx;
            if (og + 1u == (tg + 1u) * nx) xb_add(&bar[XB_TOPGEN], 1u);
            else XB_SPIN(xb_ld(&bar[XB_TOPGEN]) == tg, bar);
            __builtin_amdgcn_fence(__ATOMIC_ACQUIRE, "agent");
            xb_add(&bar[XB_XGEN(b.x)], 1u);
            asm volatile("s_waitcnt vmcnt(0)" ::: "memory");
        } else {
            XB_SPIN(xb_ld(&bar[XB_XGEN(b.x)]) == gen, bar);
            __builtin_amdgcn_fence(__ATOMIC_ACQUIRE, "agent");
            asm volatile("s_waitcnt vmcnt(0)" ::: "memory");
        }
    }
    __syncthreads();
}

template <class Src>
DI void conv_item(const Src src, gbf16* WT, int K, int nblk, int item, LAS float* scr, int lane) {
    const int kb = item / nblk, nb = item % nblk, k0 = 64 * kb, n0 = 32 * nb;
#pragma unroll 8
    for (int i = 0; i < 32; ++i) { const int kk = 2 * i + (lane >> 5); scr[kk * 33 + (lane & 31)] = src(k0 + kk, n0 + (lane & 31)); }
    asm volatile("s_waitcnt lgkmcnt(0)" ::: "memory");
    const int c = lane & 7;
#pragma unroll
    for (int j = 0; j < 4; ++j) { const int n = (lane >> 3) + 8 * j; const LAS float* s = scr + (8 * c) * 33 + n;
        u32x4 o; o.x = pk2(s[0 * 33], s[1 * 33]); o.y = pk2(s[2 * 33], s[3 * 33]); o.z = pk2(s[4 * 33], s[5 * 33]); o.w = pk2(s[6 * 33], s[7 * 33]);
        *(gu32x4*)(WT + (size_t)(n0 + n) * K + k0 + 8 * c) = o; }
    asm volatile("s_waitcnt lgkmcnt(0)" ::: "memory");
}
template <class Src>
DI void conv_item4(const Src src, gbf16* WT, int K, int nblk, int item, LAS float* scr, int lane) {
    const int kb = item / nblk, nb = item % nblk, k0 = 64 * kb, n0 = 32 * nb;
    f32x4 v[8];
#pragma unroll
    for (int i = 0; i < 8; ++i) v[i] = src.load4(k0 + 8 * i + (lane >> 3), n0 + 4 * (lane & 7));
#pragma unroll
    for (int i = 0; i < 8; ++i) { LAS float* d = scr + (8 * i + (lane >> 3)) * 33 + 4 * (lane & 7); d[0] = v[i].x; d[1] = v[i].y; d[2] = v[i].z; d[3] = v[i].w; }
    asm volatile("s_waitcnt lgkmcnt(0)" ::: "memory");
    const int c = lane & 7;
#pragma unroll
    for (int j = 0; j < 4; ++j) { const int n = (lane >> 3) + 8 * j; const LAS float* s = scr + (8 * c) * 33 + n;
        u32x4 o; o.x = pk2(s[0 * 33], s[1 * 33]); o.y = pk2(s[2 * 33], s[3 * 33]); o.z = pk2(s[4 * 33], s[5 * 33]); o.w = pk2(s[6 * 33], s[7 * 33]);
        *(gu32x4*)(WT + (size_t)(n0 + n) * K + k0 + 8 * c) = o; }
    asm volatile("s_waitcnt lgkmcnt(0)" ::: "memory");
}
struct SrcUp { const gf32* w1; const gf32* w3; const gf32* g;
    DI float operator()(int k, int n) const { const int j = (n >> 8) * 128 + (n & 127); const uintptr_t d = (uintptr_t)w3 - (uintptr_t)w1;
        const gf32* w = (const gf32*)((uintptr_t)w1 + ((n & 128) ? d : (uintptr_t)0)); return w[(size_t)k * DFF + j] * g[k]; }
    DI f32x4 load4(int k, int n) const { const int j = (n >> 8) * 128 + (n & 127); const uintptr_t d = (uintptr_t)w3 - (uintptr_t)w1;
        const gf32* w = (const gf32*)((uintptr_t)w1 + ((n & 128) ? d : (uintptr_t)0)); return *(const gf32x4*)(w + (size_t)k * DFF + j) * g[k]; } };
struct SrcPlain { const gf32* w; int N;
    DI float operator()(int k, int n) const { return w[(size_t)k * N + n]; }
    DI f32x4 load4(int k, int n) const { return *(const gf32x4*)(w + (size_t)k * N + n); } };
struct SrcIn { const gf32* w; const gf32* g;
    DI float operator()(int k, int n) const {
        int s;
        if (n < 5120) s = n;
        else if (n < 5152) { const int j = n - 5120; s = 5120 + (j >> 1) + 16 * (j & 1); }
        else if (n < 5376) s = -1;
        else if (n < 6144) s = 5152 + (n - 5376);
        else if (n < 7168) s = 5920 + (n - 6144);
        else s = 6944 + (n - 7168);
        return s < 0 ? 0.f : w[(size_t)k * N_IN + s] * g[k]; }
    DI f32x4 load4(int k, int n) const {
        if (n >= 5120 && n < 5152) return (f32x4){(*this)(k, n), (*this)(k, n + 1), (*this)(k, n + 2), (*this)(k, n + 3)};
        if (n >= 5152 && n < 5376) return (f32x4){0.f, 0.f, 0.f, 0.f};
        const int s = n < 5120 ? n : (n < 6144 ? 5152 + (n - 5376) : (n < 7168 ? 5920 + (n - 6144) : 6944 + (n - 7168)));
        return *(const gf32x4*)(w + (size_t)k * N_IN + s) * g[k]; } };
struct SrcUq { const gf32* w; const gf32* g;
    DI float operator()(int k, int n) const { int s; if (n < 512) s = (n >> 6) * 96 + (n & 63); else { const int j = n - 512, hh = j >> 5, jj = j & 31; s = hh * 96 + 64 + (jj >> 1) + 16 * (jj & 1); }
        return w[(size_t)k * 768 + s] * g[k]; } };
struct SrcUkv { const gf32* w; const gf32* g;
    DI float operator()(int k, int n) const { if (k >= 128) return 0.f; const int s = (n < 512) ? (n >> 6) * 128 + (n & 63) : ((n - 512) >> 6) * 128 + 64 + (n & 63);
        return w[(size_t)k * 1024 + s] * g[k]; }
    DI f32x4 load4(int k, int n) const { if (k >= 128) return (f32x4){0.f, 0.f, 0.f, 0.f}; const int s = (n < 512) ? (n >> 6) * 128 + (n & 63) : ((n - 512) >> 6) * 128 + 64 + (n & 63);
        return *(const gf32x4*)(w + (size_t)k * 1024 + s) * g[k]; } };
struct SrcLru { const gf32* wa; const gf32* wx;
    DI float operator()(int k, int n) const { const int b = n >> 8, dir = (n >> 7) & 1, e = (n & 127) >> 1, jq = k >> 6, ei = k & 63; if (jq != (b & 1)) return 0.f;
        const uintptr_t d = (uintptr_t)wx - (uintptr_t)wa; const gf32* w = (const gf32*)((uintptr_t)wa + ((n & 1) ? d : (uintptr_t)0)); return w[((size_t)(dir * 8 + b) * 64 + ei) * 64 + e]; } };
struct SrcBr { const gf32* w;
    DI float operator()(int k, int n) const { return w[(size_t)k * DM + n]; }
    DI f32x4 load4(int k, int n) const { return *(const gf32x4*)(w + (size_t)k * DM + n); } };

#ifndef PH_P0
#define PH_P0 1
#endif
#ifndef PH_WCONV
#define PH_WCONV 1
#endif
#ifndef PH_M1
#define PH_M1 1
#endif
#ifndef PH_M2A
#define PH_M2A 1
#endif
#ifndef PH_M2B
#define PH_M2B 1
#endif
#ifndef PH_M2C
#define PH_M2C 1
#endif
#ifndef PH_M3
#define PH_M3 1
#endif
#ifndef PH_MX
#define PH_MX 1
#endif
#ifndef PH_S1
#define PH_S1 1
#endif
#ifndef PH_MY
#define PH_MY 1
#endif
#ifndef PH_S2
#define PH_S2 1
#endif
#ifndef PH_MZ
#define PH_MZ 1
#endif
#ifndef PH_S3
#define PH_S3 1
#endif
#ifndef PH_MERGE
#define PH_MERGE 1
#endif
#ifndef PH_M7
#define PH_M7 1
#endif
#ifndef PH_M8
#define PH_M8 1
#endif
#ifndef PH_UP
#define PH_UP 1
#endif
#ifndef PH_DN
#define PH_DN 1
#endif
#ifndef PH_FIN
#define PH_FIN 1
#endif
#ifndef REP_P0
#define REP_P0 1
#endif
#ifndef REP_WCONV
#define REP_WCONV 1
#endif
#ifndef REP_M1
#define REP_M1 1
#endif
#ifndef REP_M2A
#define REP_M2A 1
#endif
#ifndef REP_M2B
#define REP_M2B 1
#endif
#ifndef REP_M2C
#define REP_M2C 1
#endif
#ifndef REP_M3
#define REP_M3 1
#endif
#ifndef REP_MX
#define REP_MX 1
#endif
#ifndef REP_S1
#define REP_S1 1
#endif
#ifndef REP_MY
#define REP_MY 1
#endif
#ifndef REP_S2
#define REP_S2 1
#endif
#ifndef REP_MZ
#define REP_MZ 1
#endif
#ifndef REP_S3
#define REP_S3 1
#endif
#ifndef REP_MERGE
#define REP_MERGE 1
#endif
#ifndef REP_M7
#define REP_M7 1
#endif
#ifndef REP_UP
#define REP_UP 1
#endif
#ifndef REP_M8
#define REP_M8 1
#endif
#ifndef REP_DN
#define REP_DN 1
#endif
#ifndef STAG_DN
#define STAG_DN 0
#endif
#ifndef STAG_M8
#define STAG_M8 0
#endif
#ifndef STAG_M7
#define STAG_M7 0
#endif
struct Params { const float* in[27]; float* out; unsigned char* ws; };

#define GRID_BAR() do { XcdBarrier bar_; bar_.bar = (unsigned*)(kws() + WS_CTL) + CW_BAR; bar_.x = xb_xcc_id(); bar_.st = (volatile LAS unsigned*)(lds + MISC_OFF) + 8; xcd_barrier(bar_); } while (0)

__global__ void __launch_bounds__(NTHREADS, 2) trunk_fwd(Params P) {
    extern __shared__ __attribute__((aligned(16))) unsigned char lds_raw[];
    LAS unsigned char* lds = (LAS unsigned char*)lds_raw;
    (void)P;
    {
        const int tid = ltid();
        for (int u = tid; u < (LDS_BYTES - LDSCTL_OFF) / 4; u += NTHREADS) ((LAS unsigned*)(lds + LDSCTL_OFF))[u] = 0u;
        __syncthreads();
        (void)xcd_barrier_post((unsigned*)(kws() + WS_CTL) + CW_BAR, (volatile LAS unsigned*)(lds + MISC_OFF) + 8);
    }

#if PH_P0
    _Pragma("unroll 1") for (int rep_ = 0; rep_ < REP_P0; ++rep_) {
        const int tid = ltid(), lane = tid & 63, wave = tid >> 6, G = lgrid(), bid = lbid();
        gu8* ws = kws(); gbf16* XB = (gbf16*)(ws + WS_XB); gf32* SS = (gf32*)(ws + WS_SS); gf32* ROPE = (gf32*)(ws + WS_ROPE);
        const gf32* xp = kin(0); const gf32* xs = kin(1);
        for (int i = bid * NTHREADS + tid; i < 4096 * 16; i += G * NTHREADS) { const int pos = i >> 4, j = i & 15;
            const float inv = __builtin_amdgcn_exp2f(-(float)j * (13.287712379549449f / 16.f));
            const float ang = (float)pos * inv;
            double rev = (double)ang * 0.15915494309189535; rev -= (double)(long long)rev;
            ROPE[2 * i] = __builtin_amdgcn_cosf((float)rev); ROPE[2 * i + 1] = __builtin_amdgcn_sinf((float)rev); }
        for (int r = bid * NWAVES + wave; r < MTOT; r += G * NWAVES) {
            const gf32* src = (r < M_PROMPT) ? xp + (size_t)r * DM : xs + (size_t)(r - M_PROMPT) * DM;
            const gf32x4* xr = (const gf32x4*)src + lane; gu32x2* bo = (gu32x2*)(XB + (size_t)r * DM) + lane; float s = 0.f;
#pragma unroll
            for (int j = 0; j < 8; ++j) { const f32x4 v = xr[64 * j]; u32x2 w; w.x = pk2(v.x, v.y); w.y = pk2(v.z, v.w); bo[64 * j] = w;
                const float a0 = __uint_as_float(w.x << 16), a1 = __uint_as_float(w.x & 0xffff0000u), a2 = __uint_as_float(w.y << 16), a3 = __uint_as_float(w.y & 0xffff0000u); s += (a0 * a0 + a1 * a1) + (a2 * a2 + a3 * a3); }
            s = wave_sum(s);
            if (lane < 32) SS[(size_t)r * 32 + lane] = (lane == 0) ? s : 0.f;
        }
    }
#endif

#pragma unroll 1
    for (int layer = 0; layer < DEPTH; ++layer) {
#if PH_WCONV
        _Pragma("unroll 1") for (int rep_ = 0; rep_ < REP_WCONV; ++rep_) {
            const int tid = ltid(), lane = tid & 63, wave = tid >> 6, G = lgrid(), bid = lbid();
            LAS float* scr = (LAS float*)(lds + wave * 16384);
            gu8* ws = kws();
            const size_t wsz = (size_t)DM * DFF;
            constexpr int I_UP = (DM / 64) * (11264 / 32), I_DN = (DFF / 64) * (DM / 32), I_IN = (DM / 64) * (NIN_PAD / 32), I_SQ = (DM / 64) * (DM / 32);
            constexpr int I_UQ = (384 / 64) * (768 / 32), I_UKV = (128 / 64) * (1024 / 32), I_LRU = (128 / 64) * (2048 / 32);
            constexpr int NITEMS = 2 * I_UP + 2 * I_DN + I_IN + 2 * I_SQ + I_UQ + I_UKV + I_LRU;
#pragma unroll 1
            for (int it = bid * NWAVES + wave; it < NITEMS; it += G * NWAVES) {
                int r = it;
                if (r < I_UP) { const SrcUp s{kin(3) + layer * wsz, kin(4) + layer * wsz, kin(2) + layer * DM}; conv_item4(s, (gbf16*)(ws + WS_WUP), DM, 11264 / 32, r, scr, lane); continue; } r -= I_UP;
                if (r < I_UP) { const SrcUp s{kin(23) + layer * wsz, kin(24) + layer * wsz, kin(22) + layer * DM}; conv_item4(s, (gbf16*)(ws + WS_WUP) + (size_t)11264 * DM, DM, 11264 / 32, r, scr, lane); continue; } r -= I_UP;
                if (r < I_DN) { const SrcPlain s{kin(5) + layer * wsz, DM}; conv_item4(s, (gbf16*)(ws + WS_WDN), DFF, DM / 32, r, scr, lane); continue; } r -= I_DN;
                if (r < I_DN) { const SrcPlain s{kin(25) + layer * wsz, DM}; conv_item4(s, (gbf16*)(ws + WS_WDN) + (size_t)DM * DFF, DFF, DM / 32, r, scr, lane); continue; } r -= I_DN;
                if (r < I_IN) { const SrcIn s{kin(7) + (size_t)layer * DM * N_IN, kin(6) + layer * DM}; conv_item4(s, (gbf16*)(ws + WS_WIN), DM, NIN_PAD / 32, r, scr, lane); continue; } r -= I_IN;
                if (r < I_SQ) { const SrcBr s{kin(20) + (size_t)layer * 4 * 512 * DM}; conv_item4(s, (gbf16*)(ws + WS_WBR), DM, DM / 32, r, scr, lane); continue; } r -= I_SQ;
                if (r < I_SQ) { const SrcPlain s{kin(21) + (size_t)layer * DM * DM, DM}; conv_item4(s, (gbf16*)(ws + WS_WOUT), DM, DM / 32, r, scr, lane); continue; } r -= I_SQ;
                if (r < I_UQ) { const SrcUq s{kin(9) + (size_t)layer * 384 * 768, kin(8) + layer * 384}; conv_item(s, (gbf16*)(ws + WS_WUQ), 384, 768 / 32, r, scr, lane); continue; } r -= I_UQ;
                if (r < I_UKV) { const SrcUkv s{kin(11) + (size_t)layer * 128 * 1024, kin(10) + layer * 128}; conv_item4(s, (gbf16*)(ws + WS_WUKV), 128, 1024 / 32, r, scr, lane); continue; } r -= I_UKV;
                { const SrcLru s{kin(14) + (size_t)layer * 2 * 8 * 64 * 64, kin(16) + (size_t)layer * 2 * 8 * 64 * 64}; conv_item(s, (gbf16*)(ws + WS_WLRU), 128, 2048 / 32, r, scr, lane); }
            }
        }
#endif
        GRID_BAR();

#pragma unroll 1
        for (int f = 0; f < 2; ++f) {
            if (f == 1) {
#pragma unroll 1
                for (int ch = 0; ch < NCHUNK; ++ch) {
                    const int row0 = ch ? M_PROMPT : 0, mc = ch ? M_SAMPLE : M_PROMPT; const int L = ch ? 4096 : 2048; const int nseq = mc / L;
#if PH_M1
                    _Pragma("unroll 1") for (int rep_ = 0; rep_ < REP_M1; ++rep_) {
                        gu8* ws = kws();
                        pg8::Gemm g{(const gbf16*)(ws + WS_XB) + (size_t)row0 * DM, (const gbf16*)(ws + WS_WIN), mc, NIN_PAD, DM, DM, DM, 0, 0, 0}; pg8::StaticOrder S; S.init(mc, NIN_PAD, lgrid(), lbid());
                        epi::EpiProj E{row0, L - 1, (unsigned)(layer * 16 + 2 + ch)};
                        pg8::gemm_phase<epi::EpiProj, true>(lds, g, S, E);
                    }
#endif
                    GRID_BAR();
#if PH_M3
                    _Pragma("unroll 1") for (int rep_ = 0; rep_ < REP_M3; ++rep_) {
                        gu8* ws = kws();
                        pg8::Gemm g{(const gbf16*)((gu8*)kout() + OUT_XC), (const gbf16*)(ws + WS_WLRU), mc, 2048, 128, 512, 128, 1, 128, 0}; pg8::StaticOrder S; S.init(mc, 2048, lgrid(), lbid());
                        {
                            const int tid = ltid(); const gbf16* PROJ = (const gbf16*)(ws + WS_PROJ); gbf16* XC = (gbf16*)((gu8*)kout() + OUT_XC);
                            const gf32* cw = kin(12) + layer * 4 * 512; const gf32* cb = kin(13) + layer * 512;
#pragma unroll 1
                            for (int i = 0; ; ++i) { pg8::Unit u; if (!S.next(i, u)) break;
                                const int c8 = (u.pn >> 1) * 128 + (tid & 15) * 8;
                                float wv[4][8], bv[8];
                                { const f32x4 b0 = *(const gf32x4*)(cb + c8), b1 = *(const gf32x4*)(cb + c8 + 4); bv[0] = b0.x; bv[1] = b0.y; bv[2] = b0.z; bv[3] = b0.w; bv[4] = b1.x; bv[5] = b1.y; bv[6] = b1.z; bv[7] = b1.w; }
#pragma unroll
                                for (int tap = 0; tap < 4; ++tap) { const f32x4 w0 = *(const gf32x4*)(cw + tap * 512 + c8), w1 = *(const gf32x4*)(cw + tap * 512 + c8 + 4);
                                    wv[tap][0] = w0.x; wv[tap][1] = w0.y; wv[tap][2] = w0.z; wv[tap][3] = w0.w; wv[tap][4] = w1.x; wv[tap][5] = w1.y; wv[tap][6] = w1.z; wv[tap][7] = w1.w; }
#pragma unroll 4
                                for (int k = 0; k < 8; ++k) { const int row = u.pm * 256 + (tid >> 4) + 32 * k, pos = row & (L - 1);
                                    u32x4 xw[4];
#pragma unroll
                                    for (int tap = 0; tap < 4; ++tap) { const int p2 = pos + tap - 2; int rr = row + tap - 2; if (p2 < 0 || p2 >= L) rr = row; xw[tap] = *(const gu32x4*)(PROJ + (size_t)rr * NPROJ + PC_XR + c8); }
                                    float a[8];
#pragma unroll
                                    for (int e = 0; e < 8; ++e) a[e] = bv[e];
#pragma unroll
                                    for (int tap = 0; tap < 4; ++tap) { const int p2 = pos + tap - 2; float xv[8]; unpack8(xw[tap], xv); const float msk = (p2 >= 0 && p2 < L) ? 1.f : 0.f;
#pragma unroll
                                        for (int e = 0; e < 8; ++e) a[e] += (xv[e] * msk) * wv[tap][e]; }
                                    *(gu32x4*)(XC + (size_t)row * 512 + c8) = pack8(a); } }
                            __syncthreads();
                        }
                        epi::EpiLru E{layer};
                        pg8::gemm_phase<epi::EpiLru, true>(lds, g, S, E);
#if PH_S1
                        {
                            const int tid = ltid(), fb = tid >> 6, cl = tid & 63; const int NSB = L / 1024;
                            const GAS unsigned* AU2 = (const GAS unsigned*)((gu8*)kout() + OUT_AU); gf32x2* SUMF = (gf32x2*)(ws + WS_SUMF); gf32x2* SUMB = (gf32x2*)(ws + WS_SUMB);
                            gf32x2* CSF = (gf32x2*)(ws + WS_CSF); gf32x2* CSB = (gf32x2*)(ws + WS_CSB);
                            LAS f32x4* xch = (LAS f32x4*)lds;
                            __syncthreads();
#pragma unroll 1
                            for (int i = 0; ; ++i) { pg8::Unit u; if (!S.next(i, u)) break;
                                const int c = u.pn * 64 + cl, blk = u.pm * 8 + fb; const GAS unsigned* au = AU2 + (size_t)blk * 32 * 1024 + c;
                                float Pf = 1.f, Hf = 0.f, Pb = 1.f, Hb = 0.f;
#pragma unroll
                                for (int t = 0; t < 32; ++t) { const unsigned w = au[(size_t)t * 1024]; const float a = 1.f - __uint_as_float(w << 16), uu = __uint_as_float(w & 0xffff0000u); Hf = a * Hf + uu; Pf *= a; }
#pragma unroll
                                for (int t = 31; t >= 0; --t) { const unsigned w = au[(size_t)t * 1024 + 512]; const float a = 1.f - __uint_as_float(w << 16), uu = __uint_as_float(w & 0xffff0000u); Hb = a * Hb + uu; Pb *= a; }
                                SUMF[(size_t)blk * 512 + c] = (f32x2){Pf, Hf}; SUMB[(size_t)blk * 512 + c] = (f32x2){Pb, Hb};
                                xch[fb * 64 + cl] = (f32x4){Pf, Hf, Pb, Hb};
                                __syncthreads();
                                if ((fb & (NSB - 1)) == 0) { float Pcf = 1.f, Hcf = 0.f, Pcb = 1.f, Hcb = 0.f;
#pragma unroll 1
                                    for (int k = 0; k < NSB; ++k) { const f32x4 e = xch[(fb + k) * 64 + cl]; Hcf = e.x * Hcf + e.y; Pcf *= e.x; }
#pragma unroll 1
                                    for (int k = NSB - 1; k >= 0; --k) { const f32x4 e = xch[(fb + k) * 64 + cl]; Hcb = e.z * Hcb + e.w; Pcb *= e.z; }
                                    const int cbk = blk / NSB; CSF[(size_t)cbk * 512 + c] = (f32x2){Pcf, Hcf}; CSB[(size_t)cbk * 512 + c] = (f32x2){Pcb, Hcb}; }
                                __syncthreads(); }
                        }
#endif
                    }
#endif
#if PH_M2B
                    _Pragma("unroll 1") for (int rep_ = 0; rep_ < REP_M2B; ++rep_) {
                        gu8* ws = kws();
                        pg8::Gemm g{(const gbf16*)(ws + WS_PROJ) + PC_CQ, (const gbf16*)(ws + WS_WUQ), mc, 768, 384, NPROJ, 384, 0, 0, 0}; pg8::StaticOrder S; S.init(mc, 768, lgrid(), lbid());
                        epi::EpiMlaQ E{L - 1};
                        pg8::gemm_phase<epi::EpiMlaQ, true>(lds, g, S, E);
                    }
#endif
#if PH_M2C
                    _Pragma("unroll 1") for (int rep_ = 0; rep_ < REP_M2C; ++rep_) {
                        gu8* ws = kws();
                        pg8::Gemm g{(const gbf16*)(ws + WS_PROJ) + PC_CKV, (const gbf16*)(ws + WS_WUKV), mc, 1024, 128, NPROJ, 128, 0, 0, 0}; pg8::StaticOrder S; S.init(mc, 1024, lgrid(), (lbid() + 192) % lgrid());
                        epi::EpiMlaKV E{};
                        pg8::gemm_phase<epi::EpiMlaKV, true>(lds, g, S, E);
                    }
#endif
#if PH_MY
                    _Pragma("unroll 1") for (int rep_ = 0; rep_ < REP_MY; ++rep_) {
                        const int tid = ltid(), wave = __builtin_amdgcn_readfirstlane(tid >> 6), G = lgrid(), bid = lbid();
                        gu8* ws = kws(); const gbf16* PROJ = (const gbf16*)(ws + WS_PROJ); gbf16* OA = (gbf16*)((gu8*)kout() + OUT_OA); gf32* LSE = (gf32*)(ws + WS_LSE);
                        int ubase = 0;
#pragma unroll 1
                        for (int gi = 0; gi < 3; ++gi) {
                            const int dil = (gi == 0) ? 1 : (gi == 1 ? 4 : 16); const int Lv = L / dil; const int QBR = Lv < 256 ? Lv : 256; const int nqb = Lv / QBR, nvs = nseq * dil;
                            const int nun = 8 * nvs * nqb;
                            int first = (bid - ubase) % G; if (first < 0) first += G;
                            const bool xo = (G % 8 == 0) && (nun % G == 0);
                            const int u_first = xo ? (bid & 7) * (nun >> 3) + (bid >> 3) : first, u_step = xo ? (G >> 3) : G, u_end = xo ? ((bid & 7) + 1) * (nun >> 3) : nun;
#pragma unroll 1
                            for (int ui = u_first; ui < u_end; ui += u_step) { const int qb = ui % nqb, vs = (ui / nqb) % nvs, hd = ui / (nqb * nvs); const int sq = vs / dil, res = vs % dil;
                                const size_t base = (size_t)sq * L + res;
                                const int q0 = qb * QBR; int w0 = q0 - 64; if (w0 < 0) w0 = 0; int w1 = q0 + QBR + 64; if (w1 > Lv) w1 = Lv;
                                const int qw = q0 + wave * 32; const bool active = wave * 32 < QBR;
                                att::banded_unit<64, false>(lds, PROJ + base * NPROJ + PC_AK + gi * 512 + hd * 64, PROJ + base * NPROJ + PC_AV + gi * 512 + hd * 64, (size_t)dil * NPROJ, w0, w1, active,
                                                            PROJ + base * NPROJ + PC_AQ + gi * 512 + hd * 64, qw, exp2f(-(float)(hd + 1)) * (float)dil * LOG2E, 0.f,
                                                            OA + ((size_t)gi * mc + base) * 512 + hd * 64, (size_t)dil * 512, LSE + ((size_t)gi * mc + base) * 8 + hd, (size_t)dil * 8); }
                            ubase += nun;
                        }
                    }
#endif
                    GRID_BAR();
#if PH_MX
                    _Pragma("unroll 1") for (int rep_ = 0; rep_ < REP_MX; ++rep_) {
                        const int G = lgrid(), bid = lbid();
                        gu8* ws = kws(); const gbf16* PROJ = (const gbf16*)(ws + WS_PROJ); const gbf16* KVB = (const gbf16*)(ws + WS_KVB); const gbf16* QN = (const gbf16*)((gu8*)kout() + OUT_QN); const gbf16* QR = (const gbf16*)(ws + WS_QR); gbf16* Y = (gbf16*)((gu8*)kout() + OUT_Y);
                        const int nqb = L / 256, nunits = nseq * 8 * nqb;
                        const bool xo = (G % 8 == 0) && (nunits % 8 == 0); const int upx = nunits / 8;
                        const int u_first = xo ? (bid & 7) * upx + (bid >> 3) : bid, u_step = xo ? (G >> 3) : G, u_end = xo ? ((bid & 7) + 1) * upx : nunits;
#pragma unroll 1
                        for (int ui = u_first; ui < u_end; ui += u_step) { const int qb = ui % nqb, hd = (ui / nqb) & 7, sq = ui / (nqb * 8);
                            const size_t srow = (size_t)sq * L, qrow = srow + (size_t)qb * 256;
                            if (!att::mla_unit<true>(lds, KVB + srow * 1024 + hd * 64, PROJ + srow * NPROJ + PC_KR, KVB + srow * 1024 + 512 + hd * 64, L,
                                                     QN + qrow * 512 + hd * 64, QR + qrow * 256 + hd * 32, Y + qrow * DM + 512 + hd * 64))
                                att::mla_unit<false>(lds, KVB + srow * 1024 + hd * 64, PROJ + srow * NPROJ + PC_KR, KVB + srow * 1024 + 512 + hd * 64, L,
                                                     QN + qrow * 512 + hd * 64, QR + qrow * 256 + hd * 32, Y + qrow * DM + 512 + hd * 64);
                            __syncthreads(); }
                    }
#endif
#if PH_MZ
                    _Pragma("unroll 1") for (int rep_ = 0; rep_ < REP_MZ; ++rep_) {
                        const int tid = ltid(), wave = __builtin_amdgcn_readfirstlane(tid >> 6), G = lgrid(), bid = lbid();
                        gu8* ws = kws(); const gbf16* PROJ = (const gbf16*)(ws + WS_PROJ); gbf16* Y = (gbf16*)((gu8*)kout() + OUT_Y);
                        const int nqb = L / 64, nunits = nseq * 2 * nqb;
                        const gf32* sink = kin(19) + layer * 8;
                        const bool xo = (G % 8 == 0) && (nunits % G == 0);
                        const int u_first = xo ? (bid & 7) * (nunits >> 3) + (bid >> 3) : bid, u_step = xo ? (G >> 3) : G, u_end = xo ? ((bid & 7) + 1) * (nunits >> 3) : nunits;
#pragma unroll 1
                        for (int ui = u_first; ui < u_end; ui += u_step) { const int qb = ui % nqb, kvh = (ui / nqb) & 1, sq = ui / (nqb * 2);
                            const size_t base = (size_t)sq * L; const int q0 = qb * 64; int w0 = q0 - 128; if (w0 < 0) w0 = 0; int w1 = q0 + 64 + 128; if (w1 > L) w1 = L;
                            const int qh = kvh * 4 + (wave >> 1), qw = q0 + (wave & 1) * 32;
                            att::banded_unit<128, true>(lds, PROJ + base * NPROJ + PC_C + 512 + kvh * 64, PROJ + base * NPROJ + PC_C + 640 + kvh * 64, (size_t)NPROJ, w0, w1, true,
                                                        PROJ + base * NPROJ + PC_C + qh * 64, qw, exp2f(-(float)(qh + 1)) * LOG2E, sink[qh] * LOG2E,
                                                        Y + base * DM + 1024 + qh * 64, (size_t)DM, nullptr, 0); }
                    }
#endif
#if PH_MERGE
                    _Pragma("unroll 1") for (int rep_ = 0; rep_ < REP_MERGE; ++rep_) {
                        const int tid = ltid(), G = lgrid(), bid = lbid();
                        gu8* ws = kws(); gbf16* Y = (gbf16*)((gu8*)kout() + OUT_Y); const gbf16* OA = (const gbf16*)((gu8*)kout() + OUT_OA); const gf32* LSE = (const gf32*)(ws + WS_LSE);
                        for (int idx = bid * NTHREADS + tid; idx < mc * 64; idx += G * NTHREADS) { const int row = idx >> 6, hd = (idx >> 3) & 7, c8 = (idx & 63) * 8;
                            const float l0 = LSE[(size_t)row * 8 + hd], l1 = LSE[((size_t)mc + row) * 8 + hd], l2 = LSE[((size_t)2 * mc + row) * 8 + hd];
                            const float mx = fmaxf(l0, fmaxf(l1, l2)); float e0 = __expf(l0 - mx), e1 = __expf(l1 - mx), e2 = __expf(l2 - mx); const float inv = 1.f / (e0 + e1 + e2); e0 *= inv; e1 *= inv; e2 *= inv;
                            float a0[8], a1[8], a2[8]; unpack8(*(const gu32x4*)(OA + (size_t)row * 512 + c8), a0); unpack8(*(const gu32x4*)(OA + ((size_t)mc + row) * 512 + c8), a1); unpack8(*(const gu32x4*)(OA + ((size_t)2 * mc + row) * 512 + c8), a2);
                            float o[8];
#pragma unroll
                            for (int e = 0; e < 8; ++e) o[e] = e0 * a0[e] + e1 * a1[e] + e2 * a2[e];
                            *(gu32x4*)(Y + (size_t)row * DM + c8) = pack8(o); }
                    }
#endif
#if PH_S3
                    _Pragma("unroll 1") for (int rep_ = 0; rep_ < REP_S3; ++rep_) {
                        const int tid = ltid(), G = lgrid(), bid = lbid();
                        gu8* ws = kws(); const gbf16* PROJ = (const gbf16*)(ws + WS_PROJ); gbf16* Y = (gbf16*)((gu8*)kout() + OUT_Y);
                        const GAS unsigned* AU2 = (const GAS unsigned*)((gu8*)kout() + OUT_AU); const gf32x2* SUMF = (const gf32x2*)(ws + WS_SUMF); const gf32x2* SUMB = (const gf32x2*)(ws + WS_SUMB);
                        const gf32x2* CSF = (const gf32x2*)(ws + WS_CSF); const gf32x2* CSB = (const gf32x2*)(ws + WS_CSB);
                        const int NC = L / 32, NSB = L / 1024;
                        for (int idx = bid * NTHREADS + tid; idx < (mc / 32) * 512; idx += G * NTHREADS) { const int c = idx & 511, blk = idx >> 9, tc = blk & (NC - 1), sblk = blk - tc;
                            const int cq = tc / NSB, cb0 = (sblk / NSB), fb0 = sblk + cq * NSB;
                            const GAS unsigned* au = AU2 + (size_t)blk * 32 * 1024 + c;
                            unsigned wf[32], wb[32]; bf16_t gt[32];
#pragma unroll
                            for (int t = 0; t < 32; ++t) wf[t] = au[(size_t)t * 1024];
#pragma unroll
                            for (int t = 0; t < 32; ++t) wb[t] = au[(size_t)t * 1024 + 512];
#pragma unroll
                            for (int t = 0; t < 32; ++t) gt[t] = PROJ[((size_t)blk * 32 + t) * NPROJ + PC_GT + c];
                            float hcur = 0.f;
#pragma unroll 8
                            for (int k = 0; k < cq; ++k) { const f32x2 e = CSF[(size_t)(cb0 + k) * 512 + c]; hcur = e.x * hcur + e.y; }
#pragma unroll 1
                            for (int k = fb0; k < blk; ++k) { const f32x2 e = SUMF[(size_t)k * 512 + c]; hcur = e.x * hcur + e.y; }
                            float hf[32];
#pragma unroll
                            for (int t = 0; t < 32; ++t) { const unsigned w = wf[t]; hcur = (1.f - __uint_as_float(w << 16)) * hcur + __uint_as_float(w & 0xffff0000u); hf[t] = hcur; }
                            hcur = 0.f;
#pragma unroll 8
                            for (int k = 31; k > cq; --k) { const f32x2 e = CSB[(size_t)(cb0 + k) * 512 + c]; hcur = e.x * hcur + e.y; }
#pragma unroll 1
                            for (int k = fb0 + NSB - 1; k > blk; --k) { const f32x2 e = SUMB[(size_t)k * 512 + c]; hcur = e.x * hcur + e.y; }
#pragma unroll
                            for (int t = 31; t >= 0; --t) { const unsigned w = wb[t]; hcur = (1.f - __uint_as_float(w << 16)) * hcur + __uint_as_float(w & 0xffff0000u);
                                const size_t row = (size_t)blk * 32 + t; const float gx = bf2f(gt[t]);
                                const float ge = gx * __builtin_amdgcn_rcpf(1.f + __builtin_amdgcn_exp2f((-2.f * LOG2E * 0.7978845608028654f) * (gx + 0.044715f * gx * gx * gx)));
                                Y[row * DM + 1536 + c] = (bf16_t)f2bf((hf[t] + hcur) * ge); } }
                    }
#endif
                    GRID_BAR();
#if PH_M7
                    _Pragma("unroll 1") for (int rep_ = 0; rep_ < REP_M7; ++rep_) {
                        gu8* ws = kws();
                        pg8::Gemm g{(const gbf16*)((gu8*)kout() + OUT_Y), (const gbf16*)(ws + WS_WBR), mc, DM, DM, DM, DM, 0, 0, 0}; pg8::StaticOrder S; S.init(mc, DM, lgrid(), lbid());
                        epi::EpiBranch E{};
                        pg8::gemm_phase<epi::EpiBranch, true>(lds, g, S, E, STAG_M7);
                    }
#endif
                    GRID_BAR();
#if PH_M8
                    _Pragma("unroll 1") for (int rep_ = 0; rep_ < REP_M8; ++rep_) {
                        gu8* ws = kws();
                        pg8::Gemm g{(const gbf16*)(ws + WS_MG), (const gbf16*)(ws + WS_WOUT), mc, DM, DM, DM, DM, 0, 0, 0}; pg8::StaticOrder S; S.init(mc, DM, lgrid(), lbid());
                        epi::EpiResidual E{row0, rep_ == REP_M8 - 1 ? 1.0f : 0.0f};
                        pg8::gemm_phase<epi::EpiResidual, true>(lds, g, S, E, STAG_M8);
                    }
#endif
                    GRID_BAR();
                }
            }
#if PH_UP
            _Pragma("unroll 1") for (int rep_ = 0; rep_ < REP_UP; ++rep_) {
                gu8* ws = kws();
                pg8::Gemm g{(const gbf16*)(ws + WS_XB), (const gbf16*)(ws + WS_WUP) + (size_t)f * 11264 * DM, MTOT, 11264, DM, DM, DM, 0, 0, 0}; pg8::StaticOrder S; S.init(MTOT, 11264, lgrid(), lbid(), 0, 1 << 30, 0, 8);
                epi::EpiSwiGLU E{(unsigned)(layer * 16 + 1 + 8 * f)};
                pg8::gemm_phase<epi::EpiSwiGLU, true>(lds, g, S, E);
            }
#endif
            GRID_BAR();
#if PH_DN
            _Pragma("unroll 1") for (int rep_ = 0; rep_ < REP_DN; ++rep_) {
                gu8* ws = kws();
                pg8::Gemm g{(const gbf16*)(ws + WS_BIG), (const gbf16*)(ws + WS_WDN) + (size_t)f * DM * DFF, MTOT, DM, DFF, 64, DFF, 0, 0, 1}; pg8::StaticOrder S; S.init(MTOT, DM, lgrid(), lbid());
                epi::EpiResidual E{0, rep_ == REP_DN - 1 ? 0.5f : 0.0f};
                pg8::gemm_phase<epi::EpiResidual, true>(lds, g, S, E, STAG_DN);
            }
#endif
            GRID_BAR();
        }
    }
#if PH_FIN
    {
        const int tid = ltid(), lane = tid & 63, wave = tid >> 6, G = lgrid(), bid = lbid();
        gu8* ws = kws(); gf32* X = kout(); const gf32* SS = (const gf32*)(ws + WS_SS); const gbf16* XB = (const gbf16*)(ws + WS_XB);
        const gf32* gn = kin(26);
        const unsigned tmo = __hip_atomic_load((unsigned*)(ws + WS_CTL) + CW_BAR + XB_TMO, __ATOMIC_RELAXED, __HIP_MEMORY_SCOPE_AGENT);
        for (int r = (bid * NWAVES + wave) * 2; r < MTOT; r += G * NWAVES * 2) {
            u32x2 w[2][8];
#pragma unroll
            for (int q = 0; q < 2; ++q) { const gu32x2* bi = (const gu32x2*)(XB + (size_t)(r + q) * DM) + lane;
#pragma unroll
                for (int j = 0; j < 8; ++j) w[q][j] = bi[64 * j]; }
            float s0 = (lane < 32) ? SS[(size_t)r * 32 + lane] : 0.f, s1 = (lane < 32) ? SS[(size_t)(r + 1) * 32 + lane] : 0.f; s0 = wave_sum(s0); s1 = wave_sum(s1);
            float rstd[2] = {rsqrtf(s0 * (1.f / (float)DM) + EPS), rsqrtf(s1 * (1.f / (float)DM) + EPS)}; if (tmo != 0u) { rstd[0] = __builtin_nanf(""); rstd[1] = rstd[0]; }
            const gf32x4* gp = (const gf32x4*)gn + lane;
#pragma unroll
            for (int j = 0; j < 8; ++j) { const f32x4 gg = gp[64 * j];
#pragma unroll
                for (int q = 0; q < 2; ++q) { gf32x4* xo = (gf32x4*)(X + (size_t)(r + q) * DM) + lane;
                    const f32x4 v = (f32x4){__uint_as_float(w[q][j].x << 16), __uint_as_float(w[q][j].x & 0xffff0000u), __uint_as_float(w[q][j].y << 16), __uint_as_float(w[q][j].y & 0xffff0000u)};
                    __builtin_nontemporal_store(v * rstd[q] * gg, xo + 64 * j); } }
        }
    }
#endif
}

extern "C" void kernel_launch(void* const* d_in, const int* in_sizes, int n_in, void* d_out, int out_size, void* d_ws, size_t ws_size, hipStream_t stream) {
    static int grid = 0;
    if (grid == 0) {
        if (n_in != 27 || out_size != MTOT * DM || ws_size < WS_END) { fprintf(stderr, "kernel_launch: unexpected problem (n_in %d, out %d, ws %zu, need %zu); nothing launched\n", n_in, out_size, ws_size, (size_t)WS_END); grid = -1; return; }
        int dev = 0, cus = 0, per_cu = 0;
        if (hipGetDevice(&dev) != hipSuccess || hipDeviceGetAttribute(&cus, hipDeviceAttributeMultiprocessorCount, dev) != hipSuccess) { grid = -1; return; }
        if (hipFuncSetAttribute((const void*)trunk_fwd, hipFuncAttributeMaxDynamicSharedMemorySize, LDS_BYTES) != hipSuccess) { fprintf(stderr, "kernel_launch: hipFuncSetAttribute failed\n"); grid = -1; return; }
        if (hipOccupancyMaxActiveBlocksPerMultiprocessor(&per_cu, (const void*)trunk_fwd, NTHREADS, LDS_BYTES) != hipSuccess || per_cu < 1) { fprintf(stderr, "kernel_launch: occupancy query reports %d\n", per_cu); }
        (void)hipGetLastError();
        grid = cus;
    }
    if (grid < 0) return;
    (void)in_sizes;
    if (hipMemsetAsync((char*)d_ws + WS_CTL, 0, CTL_ZERO_BYTES, stream) != hipSuccess) return;
    Params p{};
    for (int i = 0; i < 27; ++i) p.in[i] = (const float*)d_in[i];
    p.out = (float*)d_out; p.ws = (unsigned char*)d_ws;
    hipLaunchKernelGGL(trunk_fwd, dim3(grid), dim3(NTHREADS), LDS_BYTES, stream, p);
}
```
